# Optimizing an MI355X kernel written in HIP

```python
import math
import jax, jax.numpy as jnp
from jax import lax
import numpy as np

D_MODEL = 1024
BATCH = 8
SEQ = 4096
DEPTH = 4

N_MIXERS = 3
HEAD_DIM = 64
MIX_WIDTH = D_MODEL
MEM_LEN = 256
MEM_HEADS = 4
MEM_WIDTH = MEM_HEADS * HEAD_DIM
TOK_WIDTH = MIX_WIDTH - MEM_WIDTH

NSA_HEADS = TOK_WIDTH // HEAD_DIM
NSA_GROUPS = 4
NSA_REP = NSA_HEADS // NSA_GROUPS
NSA_KV = NSA_GROUPS * HEAD_DIM
CMP_BLOCK = 32
CMP_STRIDE = 16
CMP_HIDDEN = 256
SEL_BLOCK = 64
SEL_TOPK = 16
WINDOW = 512
Q_BLOCK = 128
FORCE_SCORE = 1.0e4
NSA_SIZES = (TOK_WIDTH, NSA_KV, NSA_KV, NSA_KV, NSA_KV, NSA_KV, NSA_KV, 3 * NSA_HEADS)
NSA_COLS = sum(NSA_SIZES) + MEM_WIDTH

REL_BUCKETS = 32
REL_MAX_DIST = 128

GLA_HEADS = 4
GLA_DV = TOK_WIDTH // GLA_HEADS
GLA_DK = GLA_DV // 2
GLA_GATE_RANK = 16
GLA_GATE_NORM = 16.0
GLA_CHUNK = 64
GLA_SIZES = (GLA_HEADS * GLA_DK, GLA_HEADS * GLA_DK, TOK_WIDTH, GLA_GATE_RANK, TOK_WIDTH)
GLA_COLS = sum(GLA_SIZES) + MEM_WIDTH

RWKV_HEADS = TOK_WIDTH // HEAD_DIM
RWKV_DECAY_LORA = 64
RWKV_AAA_LORA = 64
RWKV_GATE_LORA = 128
RWKV_SIZES = (TOK_WIDTH, RWKV_DECAY_LORA, TOK_WIDTH, TOK_WIDTH, RWKV_AAA_LORA, RWKV_GATE_LORA)
RWKV_TOK_COLS = sum(RWKV_SIZES)
RWKV_COLS = RWKV_TOK_COLS + MEM_WIDTH
RWKV_GN_EPS = 64e-5

N_EXPERTS = 32
TOP_K = 4
D_FF = D_MODEL
SWIGLU_ALPHA = 1.702
SWIGLU_LIMIT = 7.0
MOE_BLOCK = 256

DEEP_ALPHA = (2 * DEPTH) ** 0.25
DEEP_BETA = (8 * DEPTH) ** -0.25
N_NSA = (DEPTH + 2) // 3
N_GLA = (DEPTH + 1) // 3
N_RWKV = DEPTH // 3
LN_EPS = 1e-5
NEG_INF = -1e30

kernel_name = 'hybrid_nsa_gla_rwkv7_moe_deepnorm'


def _split(h, sizes):
    out, start = [], 0
    for s in sizes:
        out.append(h[..., start:start + s])
        start += s
    return out


def _layer_norm(x, g, b):
    xf = x.astype(jnp.float32)
    mu = xf.mean(-1, keepdims=True)
    var = jnp.square(xf - mu).mean(-1, keepdims=True)
    return ((xf - mu) * lax.rsqrt(var + LN_EPS) * g + b).astype(x.dtype)


def _masked_softmax(s, mask):
    s = jnp.where(mask, s.astype(jnp.float32), NEG_INF)
    e = jnp.where(mask, jnp.exp(s - s.max(-1, keepdims=True)), 0.0)
    return e / jnp.maximum(e.sum(-1, keepdims=True), 1e-30)


def _t5_bucket(dist):
    exact = REL_BUCKETS // 2
    d = jnp.maximum(dist, 0)
    scaled = jnp.log(jnp.maximum(d, 1).astype(jnp.float32) / exact) / math.log(REL_MAX_DIST / exact)
    large = jnp.minimum(exact + (scaled * (REL_BUCKETS - exact)).astype(jnp.int32), REL_BUCKETS - 1)
    return jnp.where(d < exact, d, large)


def _rel_bias(tbl, dist):
    return jnp.transpose(tbl[_t5_bucket(dist)], (2, 3, 0, 1)).astype(jnp.float32)


def _rows(arr, b, s0, n):
    start = (b, s0) + (0,) * (arr.ndim - 2)
    return lax.dynamic_slice(arr, start, (1, n) + arr.shape[2:])[0]


def _nsa_mixer(hm, rel_table, gate_b, cmp_pe, cmp_w1, cmp_w2):
    B, S, _ = hm.shape
    G, R, Dh = NSA_GROUPS, NSA_REP, HEAD_DIM
    q, kc, vc, ks, vs, kw, vw, gl = _split(hm, NSA_SIZES)
    q = (q * Dh ** -0.5).reshape(B, S, G, R, Dh)
    gates = jax.nn.sigmoid((gl + gate_b).astype(jnp.float32)).reshape(B, S, G, R, 3)
    kvh = lambda t: t.reshape(B, S, G, Dh)
    nc = (S - CMP_BLOCK) // CMP_STRIDE + 1
    cmp_start = jnp.arange(nc) * CMP_STRIDE
    cmp_end = cmp_start + CMP_BLOCK - 1
    blk_idx = cmp_start[:, None] + jnp.arange(CMP_BLOCK)[None, :]

    def compress(t, pe, w1, w2):
        tb = kvh(t)[:, blk_idx] + pe[:, None, :]
        tb = tb.transpose(0, 1, 3, 2, 4).reshape(B, nc, G, CMP_BLOCK * Dh)
        return jax.nn.gelu(tb @ w1) @ w2

    kc = compress(kc, cmp_pe[0], cmp_w1[0], cmp_w2[0])
    vc = compress(vc, cmp_pe[1], cmp_w1[1], cmp_w2[1])
    ns = S // SEL_BLOCK
    n_sel = min(SEL_TOPK, ns)
    sel_start = jnp.arange(ns) * SEL_BLOCK
    cmp_to_sel = ((cmp_start[:, None] < sel_start[None, :] + SEL_BLOCK)
                  & (cmp_end[:, None] >= sel_start[None, :])).astype(jnp.float32)
    ks = kvh(ks).reshape(B, ns, SEL_BLOCK, G, Dh).transpose(0, 3, 1, 2, 4)
    vs = kvh(vs).reshape(B, ns, SEL_BLOCK, G, Dh).transpose(0, 3, 1, 2, 4)
    kw = jnp.pad(kvh(kw), ((0, 0), (WINDOW, 0), (0, 0), (0, 0)))
    vw = jnp.pad(kvh(vw), ((0, 0), (WINDOW, 0), (0, 0), (0, 0)))
    tbl = rel_table.reshape(REL_BUCKETS, G, R)
    tbl_g = tbl.transpose(1, 0, 2)
    g_ix = jnp.arange(G)
    nq = S // Q_BLOCK

    def step(i):
        b, c = i // nq, i % nq
        s0 = c * Q_BLOCK
        tq = s0 + jnp.arange(Q_BLOCK)
        qb = _rows(q, b, s0, Q_BLOCK)
        gq = _rows(gates, b, s0, Q_BLOCK)
        kcb = lax.dynamic_index_in_dim(kc, b, 0, keepdims=False)
        vcb = lax.dynamic_index_in_dim(vc, b, 0, keepdims=False)
        dist_c = tq[:, None] - cmp_end[None, :]
        p_c = _masked_softmax(jnp.einsum('qgrd,ngd->grqn', qb, kcb) + _rel_bias(tbl, dist_c), dist_c >= 0)
        o_c = jnp.einsum('grqn,ngd->qgrd', p_c, vcb)
        imp = jnp.einsum('grqn,nm->gqm', p_c, cmp_to_sel)
        blk = jnp.arange(ns)[None, :]
        cur = (tq // SEL_BLOCK)[:, None]
        forced = (blk == 0) | (blk == cur) | (blk == cur - 1)
        score = jnp.where(blk <= cur, jnp.where(forced, FORCE_SCORE, imp), -1.0)
        top_s, top_i = lax.top_k(score, n_sel)
        ksb = lax.dynamic_index_in_dim(ks, b, 0, keepdims=False)
        vsb = lax.dynamic_index_in_dim(vs, b, 0, keepdims=False)
        ksel = ksb[g_ix[:, None, None], top_i]
        vsel = vsb[g_ix[:, None, None], top_i]
        dist_s = tq[None, :, None, None] - (top_i[..., None] * SEL_BLOCK + jnp.arange(SEL_BLOCK))
        mask_s = (top_s >= 0)[..., None] & (dist_s >= 0)
        bias_s = jnp.transpose(tbl_g[g_ix[:, None, None, None], _t5_bucket(dist_s)], (0, 4, 1, 2, 3))
        s_s = jnp.einsum('qgrd,gqnld->grqnl', qb, ksel).astype(jnp.float32) + bias_s
        nk = n_sel * SEL_BLOCK
        p_s = _masked_softmax(s_s.reshape(G, R, Q_BLOCK, nk), mask_s.reshape(G, 1, Q_BLOCK, nk))
        o_s = jnp.einsum('grqk,gqkd->qgrd', p_s, vsel.reshape(G, Q_BLOCK, nk, Dh))
        kwb = _rows(kw, b, s0, Q_BLOCK + WINDOW)
        vwb = _rows(vw, b, s0, Q_BLOCK + WINDOW)
        kpos = s0 - WINDOW + jnp.arange(Q_BLOCK + WINDOW)
        dist_w = tq[:, None] - kpos[None, :]
        mask_w = (dist_w >= 0) & (dist_w < WINDOW) & (kpos[None, :] >= 0)
        p_w = _masked_softmax(jnp.einsum('qgrd,kgd->grqk', qb, kwb) + _rel_bias(tbl, dist_w), mask_w)
        o_w = jnp.einsum('grqk,kgd->qgrd', p_w, vwb)
        o = gq[..., 0:1] * o_c + gq[..., 1:2] * o_s + gq[..., 2:3] * o_w
        return o.reshape(Q_BLOCK, TOK_WIDTH).astype(hm.dtype)

    out = lax.map(step, jnp.arange(B * nq))
    return out.reshape(B, S, TOK_WIDTH)


def _gla_mixer(hm, w_a2, b_a, b_og, norm_w):
    B, S, _ = hm.shape
    H, dk, dv, C = GLA_HEADS, GLA_DK, GLA_DV, GLA_CHUNK
    n = S // C
    f32 = jnp.float32
    q, k, v, alr, og = _split(hm, GLA_SIZES)
    gk = jax.nn.log_sigmoid((alr @ w_a2 + b_a).astype(f32)) / GLA_GATE_NORM
    rs = lambda t, d: t.astype(f32).reshape(B, n, C, H, d)
    q = rs(q, dk) * dk ** -0.5
    k = rs(k, dk)
    v = rs(v, dv)
    bcum = jnp.cumsum(rs(gk, dk), axis=2)
    blast = bcum[:, :, -1]
    qd = q * jnp.exp(bcum)
    kd = k * jnp.exp(-bcum)
    causal = jnp.tril(jnp.ones((C, C), bool))
    a = jnp.where(causal, jnp.einsum('bnchk,bnshk->bnhcs', qd, kd), 0.0)
    o_intra = jnp.einsum('bnhcs,bnshv->bnchv', a, v)
    d_state = jnp.einsum('bnchk,bnchv->bnhkv', k * jnp.exp(blast[:, :, None] - bcum), v)

    def chunk_step(state, inp):
        dec, ds = inp
        return dec[..., None] * state + ds, state

    _, s_prev = lax.scan(chunk_step, jnp.zeros((B, H, dk, dv), f32),
                         (jnp.exp(blast).transpose(1, 0, 2, 3), d_state.transpose(1, 0, 2, 3, 4)))
    s_prev = s_prev.transpose(1, 0, 2, 3, 4)
    o = (o_intra + jnp.einsum('bnchk,bnhkv->bnchv', qd, s_prev)).reshape(B, S, H, dv)
    o = o * lax.rsqrt(jnp.square(o).mean(-1, keepdims=True) + LN_EPS) * norm_w
    return o.reshape(B, S, TOK_WIDTH) * jax.nn.silu((og + b_og).astype(f32))


def _rwkv7_mixer(hm, mu, w0, w2, a0, a2, g2, k_k, k_a, r_k, ln_w, ln_b):
    B, S, _ = hm.shape
    H, N = RWKV_HEADS, HEAD_DIM
    f32 = jnp.float32
    hm = hm.astype(f32)
    prev = jnp.pad(hm, ((0, 0), (1, 0), (0, 0)))[:, :S]
    hm = hm + (prev - hm) * mu
    r, wl, k, v, al, gl = _split(hm, RWKV_SIZES)
    w = -jax.nn.softplus(-(w0 + jnp.tanh(wl) @ w2)) - 0.5
    decay = jnp.exp(-jnp.exp(w))
    a = jax.nn.sigmoid(a0 + al @ a2)
    g = jax.nn.sigmoid(gl) @ g2
    hd = lambda t: t.reshape(B, S, H, N)
    kk = hd(k * k_k)
    kk = kk / jnp.maximum(jnp.linalg.norm(kk, axis=-1, keepdims=True), 1e-12)
    k = k * (1.0 + (a - 1.0) * k_a)
    r, k, v, a, decay = hd(r), hd(k), hd(v), hd(a), hd(decay)

    def step(state, inp):
        r_t, w_t, k_t, v_t, a_t, b_t = inp
        sa = jnp.einsum('bhvk,bhk->bhv', state, a_t)
        state = state * w_t[:, :, None, :] + sa[..., None] * b_t[:, :, None, :] + v_t[..., None] * k_t[:, :, None, :]
        return state, jnp.einsum('bhvk,bhk->bhv', state, r_t)

    tm = lambda t: jnp.swapaxes(t, 0, 1)
    _, o = lax.scan(step, jnp.zeros((B, H, N, N), f32),
                    (tm(r), tm(decay), tm(k), tm(v), tm(-kk), tm(kk * a)))
    o = tm(o)
    o_mu = o.mean(-1, keepdims=True)
    o_var = jnp.square(o - o_mu).mean(-1, keepdims=True)
    o = ((o - o_mu) * lax.rsqrt(o_var + RWKV_GN_EPS)).reshape(B, S, TOK_WIDTH) * ln_w + ln_b
    o = o + ((r * k * r_k).sum(-1, keepdims=True) * v).reshape(B, S, TOK_WIDTH)
    return o * g


def _memory_attention(qm, mem, w_kv):
    B, S, _ = qm.shape
    M = mem.shape[1]
    kv = mem @ w_kv
    km = kv[..., :MEM_WIDTH].reshape(B, M, MEM_HEADS, HEAD_DIM)
    vm = kv[..., MEM_WIDTH:].reshape(B, M, MEM_HEADS, HEAD_DIM)
    qh = qm.reshape(B, S, MEM_HEADS, HEAD_DIM) * HEAD_DIM ** -0.5
    p = jax.nn.softmax(jnp.einsum('bshd,bmhd->bhsm', qh, km).astype(jnp.float32), axis=-1)
    return jnp.einsum('bhsm,bmhd->bshd', p, vm).reshape(B, S, MEM_WIDTH)


def _clamped_swiglu(h):
    glu = jnp.minimum(h[..., :D_FF], SWIGLU_LIMIT)
    lin = jnp.clip(h[..., D_FF:], -SWIGLU_LIMIT, SWIGLU_LIMIT)
    return glu * jax.nn.sigmoid(SWIGLU_ALPHA * glu) * (lin + 1.0)


def _moe(x, router_w, router_b, w_gu, b_gu, w_dn, b_dn):
    B, S, D = x.shape
    T = B * S
    A = T * TOP_K
    xt = x.reshape(T, D)
    logits = (xt @ router_w + router_b).astype(jnp.float32)
    top_val, top_idx = lax.top_k(logits, TOP_K)
    gates = jax.nn.softmax(top_val, axis=-1)
    flat_e = top_idx.reshape(-1)
    order = jnp.argsort(flat_e)
    sorted_e = flat_e[order]
    counts = jnp.bincount(flat_e, length=N_EXPERTS)
    padded = (counts + MOE_BLOCK - 1) // MOE_BLOCK * MOE_BLOCK
    pad_end = jnp.cumsum(padded)
    pad_start = pad_end - padded
    grp_start = jnp.cumsum(counts) - counts
    dest = pad_start[sorted_e] + jnp.arange(A) - grp_start[sorted_e]
    n_blocks = -(-A // MOE_BLOCK) + N_EXPERTS
    n_rows = n_blocks * MOE_BLOCK
    row_token = jnp.full((n_rows,), T, jnp.int32).at[dest].set((order // TOP_K).astype(jnp.int32))
    row_gate = jnp.zeros((n_rows,), jnp.float32).at[dest].set(gates.reshape(-1)[order])
    block_expert = jnp.minimum(jnp.searchsorted(pad_end, jnp.arange(n_blocks) * MOE_BLOCK, side='right'),
                               N_EXPERTS - 1)
    x_pad = jnp.concatenate([xt, jnp.zeros((1, D), xt.dtype)], axis=0)

    def expert_block(args):
        rows, gate, e = args
        h = x_pad[rows] @ w_gu[e] + b_gu[e]
        y = _clamped_swiglu(h.astype(jnp.float32)) @ w_dn[e] + b_dn[e]
        return y * gate[:, None]

    y_rows = lax.map(expert_block, (row_token.reshape(n_blocks, MOE_BLOCK),
                                    row_gate.reshape(n_blocks, MOE_BLOCK), block_expert))
    out = jnp.zeros((T + 1, D), y_rows.dtype).at[row_token].add(y_rows.reshape(n_rows, D))[:T]
    return out.reshape(B, S, D).astype(x.dtype)


def setup_inputs(seed: int = 0) -> dict:
    key = jax.random.key(seed)
    keys = iter(jax.random.split(key, 64))

    def nrm(shape, scale):
        return jax.random.normal(next(keys), shape, jnp.float32) * scale

    def near_one(shape):
        return 1.0 + nrm(shape, 0.02)

    D = D_MODEL
    return {
        'x': nrm((BATCH, SEQ, D), 1.0),
        'mem': nrm((BATCH, MEM_LEN, D), 1.0),
        'rel_table': nrm((REL_BUCKETS, NSA_HEADS), 0.5),
        'nsa_w_in': nrm((N_NSA, D, NSA_COLS), D ** -0.5),
        'nsa_gate_b': nrm((N_NSA, 3 * NSA_HEADS), 0.1),
        'nsa_cmp_pe': nrm((N_NSA, 2, CMP_BLOCK, HEAD_DIM), 0.1),
        'nsa_cmp_w1': nrm((N_NSA, 2, CMP_BLOCK * HEAD_DIM, CMP_HIDDEN), (CMP_BLOCK * HEAD_DIM) ** -0.5),
        'nsa_cmp_w2': nrm((N_NSA, 2, CMP_HIDDEN, HEAD_DIM), CMP_HIDDEN ** -0.5),
        'gla_w_in': nrm((N_GLA, D, GLA_COLS), D ** -0.5),
        'gla_w_a2': nrm((N_GLA, GLA_GATE_RANK, GLA_HEADS * GLA_DK), GLA_GATE_RANK ** -0.5),
        'gla_b_a': nrm((N_GLA, GLA_HEADS * GLA_DK), 0.1),
        'gla_b_og': nrm((N_GLA, TOK_WIDTH), 0.02),
        'gla_norm_w': near_one((N_GLA, GLA_DV)),
        'rwkv_w_in': nrm((N_RWKV, D, RWKV_COLS), D ** -0.5),
        'rwkv_mu': jax.random.uniform(next(keys), (N_RWKV, RWKV_TOK_COLS), jnp.float32),
        'rwkv_w0': nrm((N_RWKV, TOK_WIDTH), 0.5),
        'rwkv_w2': nrm((N_RWKV, RWKV_DECAY_LORA, TOK_WIDTH), 0.1),
        'rwkv_a0': nrm((N_RWKV, TOK_WIDTH), 0.1),
        'rwkv_a2': nrm((N_RWKV, RWKV_AAA_LORA, TOK_WIDTH), 0.1),
        'rwkv_g2': nrm((N_RWKV, RWKV_GATE_LORA, TOK_WIDTH), RWKV_GATE_LORA ** -0.5),
        'rwkv_k_k': near_one((N_RWKV, TOK_WIDTH)),
        'rwkv_k_a': near_one((N_RWKV, TOK_WIDTH)),
        'rwkv_r_k': nrm((N_RWKV, RWKV_HEADS, HEAD_DIM), 0.1),
        'rwkv_ln_w': near_one((N_RWKV, TOK_WIDTH)),
        'rwkv_ln_b': nrm((N_RWKV, TOK_WIDTH), 0.02),
        'mem_w_kv': nrm((DEPTH, D, 2 * MEM_WIDTH), D ** -0.5),
        'w_out': nrm((DEPTH, MIX_WIDTH, D), MIX_WIDTH ** -0.5 * DEEP_BETA),
        'ln1_g': near_one((DEPTH, D)),
        'ln1_b': nrm((DEPTH, D), 0.02),
        'ln2_g': near_one((DEPTH, D)),
        'ln2_b': nrm((DEPTH, D), 0.02),
        'router_w': nrm((DEPTH, D, N_EXPERTS), D ** -0.5),
        'router_b': nrm((DEPTH, N_EXPERTS), 0.01),
        'exp_w_gu': nrm((DEPTH, N_EXPERTS, D, 2 * D_FF), D ** -0.5),
        'exp_b_gu': nrm((DEPTH, N_EXPERTS, 2 * D_FF), 0.01),
        'exp_w_dn': nrm((DEPTH, N_EXPERTS, D_FF, D), D_FF ** -0.5 * DEEP_BETA),
        'exp_b_dn': nrm((DEPTH, N_EXPERTS, D), 0.01),
    }


def reference(x, mem, rel_table, nsa_w_in, nsa_gate_b, nsa_cmp_pe, nsa_cmp_w1, nsa_cmp_w2,
              gla_w_in, gla_w_a2, gla_b_a, gla_b_og, gla_norm_w,
              rwkv_w_in, rwkv_mu, rwkv_w0, rwkv_w2, rwkv_a0, rwkv_a2, rwkv_g2, rwkv_k_k, rwkv_k_a,
              rwkv_r_k, rwkv_ln_w, rwkv_ln_b,
              mem_w_kv, w_out, ln1_g, ln1_b, ln2_g, ln2_b,
              router_w, router_b, exp_w_gu, exp_b_gu, exp_w_dn, exp_b_dn):
    for i in range(DEPTH):
        kind, j = i % N_MIXERS, i // N_MIXERS
        if kind == 0:
            h = x @ nsa_w_in[j]
            y = _nsa_mixer(h[..., :-MEM_WIDTH], rel_table, nsa_gate_b[j], nsa_cmp_pe[j],
                           nsa_cmp_w1[j], nsa_cmp_w2[j])
        elif kind == 1:
            h = x @ gla_w_in[j]
            y = _gla_mixer(h[..., :-MEM_WIDTH], gla_w_a2[j], gla_b_a[j], gla_b_og[j], gla_norm_w[j])
        else:
            h = x @ rwkv_w_in[j]
            y = _rwkv7_mixer(h[..., :-MEM_WIDTH], rwkv_mu[j], rwkv_w0[j], rwkv_w2[j], rwkv_a0[j],
                             rwkv_a2[j], rwkv_g2[j], rwkv_k_k[j], rwkv_k_a[j], rwkv_r_k[j],
                             rwkv_ln_w[j], rwkv_ln_b[j])
        y_mem = _memory_attention(h[..., -MEM_WIDTH:], mem, mem_w_kv[i])
        mix = jnp.concatenate([y.astype(x.dtype), y_mem.astype(x.dtype)], axis=-1) @ w_out[i]
        x = _layer_norm(DEEP_ALPHA * x + mix, ln1_g[i], ln1_b[i])
        ffn = _moe(x, router_w[i], router_b[i], exp_w_gu[i], exp_b_gu[i], exp_w_dn[i], exp_b_dn[i])
        x = _layer_norm(DEEP_ALPHA * x + ffn, ln2_g[i], ln2_b[i])
    return x
```

```cpp
#include <hip/hip_runtime.h>
#include <cstdio>
#include <cstdint>

#define DI __device__ __forceinline__
typedef unsigned short bf16;
typedef unsigned v4u __attribute__((ext_vector_type(4)));
typedef unsigned v2u __attribute__((ext_vector_type(2)));
typedef float f32x4 __attribute__((ext_vector_type(4)));
typedef float f32x2 __attribute__((ext_vector_type(2)));

constexpr int D = 1024, BATCH = 8, SEQ = 4096, T = BATCH * SEQ, DEPTH = 4;
constexpr int HC = 2816;
constexpr int MEMLEN = 256, MEMW = 256, TOKW = 768;
constexpr int NSA_COLS = 2596, GLA_COLS = 2576, RWKV_COLS = 2816;
constexpr int NE = 32, TOPK = 4, NBMAX = 544, MOEROWS = NBMAX * 256;
constexpr int NC = 255;
constexpr float DEEP_ALPHA = 1.6817928305074292f;
constexpr float LN_EPS = 1e-5f;
constexpr int NQ = 0, NKC = 768, NVC = 1024, NKS = 1280, NVS = 1536, NKW = 1792, NVW = 2048, NGL = 2304, NMQ = 2340;
constexpr int GQ = 0, GK = 384, GV = 768, GALR = 1536, GOG = 1552, GMQ = 2320;
constexpr int RR = 0, RWL = 768, RK = 832, RV = 1600, RAL = 2368, RGL = 2432, RMQ = 2560;

constexpr size_t MiB = 1u << 20;
constexpr size_t WS_CTL = 0, CTL_BYTES = 1 * MiB;
constexpr size_t WS_WIN = 2 * MiB;
constexpr size_t WIN_STRIDE = 6 * MiB;
constexpr size_t WS_WOUT = 26 * MiB;
constexpr size_t WS_WKV = 34 * MiB;
constexpr size_t WS_CW1 = 38 * MiB;
constexpr size_t WS_CW2T = 44 * MiB;
constexpr size_t WS_WGU = 64 * MiB;
constexpr size_t WS_WDN = 576 * MiB;
constexpr size_t WS_XF = 832 * MiB;
constexpr size_t WS_XB = 960 * MiB;
constexpr size_t WS_H = 1024 * MiB;
constexpr size_t WS_CAT = 1376 * MiB;
constexpr size_t WS_Z = 1440 * MiB;
constexpr size_t WS_X1F = 1568 * MiB;
constexpr size_t WS_X1B = 1696 * MiB;
constexpr size_t WS_TOKE = 1760 * MiB;
constexpr size_t WS_TOKG = WS_TOKE + 512 * 1024;
constexpr size_t WS_TOKL = WS_TOKG + 512 * 1024;
constexpr size_t WS_TOKS = WS_TOKL + 512 * 1024;
constexpr size_t WS_MEMB = 1762 * MiB;
constexpr size_t WS_ROWTOK = 1766 * MiB;
constexpr size_t WS_XG = 1776 * MiB;
constexpr size_t WS_ACT = 2048 * MiB;
constexpr size_t WS_Y = 2320 * MiB;
constexpr size_t WS_MIX = 2864 * MiB;
constexpr size_t WS_HB = 3664 * MiB;
constexpr size_t WS_KVB = 3840 * MiB;
constexpr size_t WS_END = 3842 * MiB;
constexpr size_t MX_CMPA = WS_MIX;
constexpr size_t MX_CMPH = WS_MIX + 64 * MiB;
constexpr size_t MX_KC = WS_MIX + 80 * MiB;
constexpr size_t MX_VC = WS_MIX + 84 * MiB;
constexpr size_t MX_OC = WS_MIX + 88 * MiB;
constexpr size_t MX_SELM = WS_MIX + 184 * MiB;
constexpr size_t MX_KCB = WS_MIX + 186 * MiB;
constexpr size_t MX_VCB = WS_MIX + 188 * MiB;
constexpr size_t MX_OSB = WS_MIX + 190 * MiB;
constexpr size_t MX_GDEC = WS_MIX;
constexpr size_t MX_GO = WS_MIX + 48 * MiB;
constexpr size_t MX_RV0 = WS_MIX;
constexpr size_t MX_RO = WS_MIX + 672 * MiB;
constexpr size_t MX_RBON = WS_MIX + 768 * MiB;
constexpr int CW_BAR = 4096;
constexpr int CW_CNT = 1024;

constexpr int RING_BYTES = 131072, MISC_OFF = 131072, LDS_BYTES = 147456;
constexpr int MS_BAR = 0;
constexpr int MS_NB = 32;
constexpr int MS_PADS = 64;
constexpr int MS_BEXP = 256;
constexpr int MS_HIST = 1024;
constexpr int MS_BASE = 1152;
constexpr int MS_RT = 2048;

__device__ const unsigned char T5B[128] = {0, 1, 2, 3, 4, 5, 6, 7, 8, 9, 10, 11, 12, 13, 14, 15, 16, 16, 16, 17, 17, 18, 18, 18, 19, 19, 19, 20, 20, 20, 20, 21, 21, 21, 21, 22, 22, 22, 22, 22, 23, 23, 23, 23, 23, 23, 24, 24, 24, 24, 24, 24, 25, 25, 25, 25, 25, 25, 25, 26, 26, 26, 26, 26, 26, 26, 26, 27, 27, 27, 27, 27, 27, 27, 27, 27, 27, 28, 28, 28, 28, 28, 28, 28, 28, 28, 28, 29, 29, 29, 29, 29, 29, 29, 29, 29, 29, 29, 29, 30, 30, 30, 30, 30, 30, 30, 30, 30, 30, 30, 30, 30, 30, 31, 31, 31, 31, 31, 31, 31, 31, 31, 31, 31, 31, 31, 31, 31};
DI int t5_bucket(int dist) { return dist >= 128 ? 31 : T5B[dist < 0 ? 0 : dist]; }

typedef __bf16 bf16x2_hw __attribute__((ext_vector_type(2)));
DI unsigned pk2(float lo, float hi) { f32x2 v = {lo, hi}; bf16x2_hw b = __builtin_convertvector(v, bf16x2_hw); return __builtin_bit_cast(unsigned, b); }
DI unsigned f2bf(float f) { return pk2(f, 0.f) & 0xffffu; }
DI float bf2f(unsigned short b) { return __builtin_bit_cast(float, ((unsigned)b) << 16); }
DI float opq(float c) { asm volatile("" : "+v"(c)); return c; }
DI void lds_barrier() { asm volatile("s_waitcnt lgkmcnt(0)" ::: "memory"); __builtin_amdgcn_s_barrier(); asm volatile("" ::: "memory"); }
template <int CTRL> DI float dppf(float v) { return __builtin_bit_cast(float, __builtin_amdgcn_update_dpp(0, __builtin_bit_cast(int, v), CTRL, 0xf, 0xf, false)); }
DI float row_sum16(float v) {
    v += dppf<0x128>(v); v += dppf<0x124>(v); v += dppf<0x122>(v); v += dppf<0x121>(v); return v; }
DI float wave_sum(float v) {
    v = row_sum16(v); const int b = __builtin_bit_cast(int, v);
    const float r0 = __builtin_bit_cast(float, __builtin_amdgcn_readlane(b, 0)), r1 = __builtin_bit_cast(float, __builtin_amdgcn_readlane(b, 16));
    const float r2 = __builtin_bit_cast(float, __builtin_amdgcn_readlane(b, 32)), r3 = __builtin_bit_cast(float, __builtin_amdgcn_readlane(b, 48));
    return (r0 + r1) + (r2 + r3); }
DI float wave_max(float v) {
#pragma unroll
    for (int o = 1; o < 64; o <<= 1) v = fmaxf(v, __shfl_xor(v, o));
    return v;
}
DI float sigmoidf_(float x) { return 1.0f / (1.0f + __expf(-x)); }
DI float softplusf_(float x) { return fmaxf(x, 0.f) + log1pf(__expf(-fabsf(x))); }
DI float fexp(float x) { return __builtin_amdgcn_exp2f(x * 1.4426950408889634f); }
DI float flog(float x) { return __builtin_amdgcn_logf(x) * 0.6931471805599453f; }
DI float frcp(float x) { return __builtin_amdgcn_rcpf(x); }
DI float fsigmoid(float x) { return frcp(1.0f + fexp(-x)); }
DI float ftanh(float x) { return 1.0f - 2.0f * frcp(1.0f + fexp(2.0f * x)); }
DI float fsoftplus(float x) { return fmaxf(x, 0.f) + flog(1.0f + fexp(-fabsf(x))); }
DI float gelu_tanh(float x) { const float u = 0.7978845608028654f * (x + 0.044715f * x * x * x); return x * frcp(1.0f + fexp(-2.0f * u)); }

namespace pg8 {
#define PG8_LAS __attribute__((address_space(3)))
typedef unsigned short bf16_t;
typedef short bf16x8 __attribute__((ext_vector_type(8)));
typedef float f32x4 __attribute__((ext_vector_type(4)));
typedef unsigned u32x4 __attribute__((ext_vector_type(4)));
constexpr int BM = 256, BK = 64, HALF = 128, HTB = HALF * BK * 2  , STAGE_BYTES = 8 * HTB, NXCD = 8, WGM = 8;

__host__ __device__ __forceinline__ int lds_byte(int r, int c) { const int st = (r >> 4) * 2 + (c >> 5), rr = r & 15, cc = c & 31, ob = rr * 64 + cc * 2; return st * 1024 + (ob ^ (((ob >> 9) & 1) << 5)); }
__host__ __device__ __forceinline__ void stage_rc(int b, int& R, int& C) { const int st = b / 1024, sb = b % 1024, swz = sb ^ (((sb >> 9) & 1) << 5); R = (st >> 1) * 16 + swz / 64; C = (st & 1) * 32 + (swz % 64) / 2; }
__host__ __device__ __forceinline__ int perm32(int rho) { const int n = rho >> 4, i = rho & 15; return 8 * (i >> 2) + 4 * n + (i & 3); }

struct Unit { int pm, pn, e; };

struct SchedDense {
    static constexpr bool GATHER = false; __device__ __forceinline__ unsigned arow(int, int) const { return 0u; }
    const char* A; const char* Bt; int K, nM, nN, nwg, G, c;
    __device__ void init(const void* A_, const void* Bt_, int M, int N, int K_, int G_, int c_) { A = (const char*)A_; Bt = (const char*)Bt_; K = K_; nM = M / BM; nN = N / BM; nwg = nM * nN; G = G_; c = c_; }
    __device__ __forceinline__ bool next(int i, Unit& u) const {
        const long L = (long)i * G + c; if (L >= nwg) return false;
        int wgid = (int)L; { const int q = nwg / NXCD, r = nwg % NXCD, xcd = wgid % NXCD, off = wgid / NXCD; wgid = (xcd < r ? xcd * (q + 1) : r * (q + 1) + (xcd - r) * q) + off; }
        const int nig = WGM * nN, gid = wgid / nig, fm = gid * WGM, gsz = (nM - fm) < WGM ? (nM - fm) : WGM;
        u.pm = fm + ((wgid % nig) % gsz); u.pn = (wgid % nig) / gsz; u.e = 0; return true;
    }
    __device__ __forceinline__ const char* aptr(const Unit& u) const { return A + (size_t)u.pm * BM * K * 2; }
    __device__ __forceinline__ const char* bptr(const Unit& u) const { return Bt + (size_t)u.pn * BM * K * 2; }
    __device__ __forceinline__ void a_ready(const Unit&) const {}
    __device__ __forceinline__ void done(const Unit&) const {}
};
struct SchedPair {
    static constexpr bool GATHER = false; __device__ __forceinline__ unsigned arow(int, int) const { return 0u; }
    const char* A; const char* Bt; size_t strideA, strideB; int K, nM, nN, G, c;
    __device__ __forceinline__ bool next(int i, Unit& u) const {
        const int L = i * G + c, per = nM * nN; if (L >= 2 * per) return false;
        u.e = L / per; const int r = L % per; u.pm = r / nN; u.pn = r % nN; return true;
    }
    __device__ __forceinline__ const char* aptr(const Unit& u) const { return A + (size_t)u.e * strideA + (size_t)u.pm * BM * K * 2; }
    __device__ __forceinline__ const char* bptr(const Unit& u) const { return Bt + (size_t)u.e * strideB + (size_t)u.pn * BM * K * 2; }
    __device__ __forceinline__ void a_ready(const Unit&) const {}
    __device__ __forceinline__ void done(const Unit&) const {}
};
struct SchedMoe {
    static constexpr bool GATHER = false; __device__ __forceinline__ unsigned arow(int, int) const { return 0u; }
    const char* A; const char* W; const PG8_LAS unsigned char* bexp; int NB, K, nN, N, G, c;
    __device__ __forceinline__ bool next(int i, Unit& u) const {
        const int x = c & 7, q = i * (G >> 3) + (c >> 3), chunk = (NB + 7) >> 3, r = q / nN;
        u.pm = x * chunk + r; u.pn = q % nN; if (r >= chunk || u.pm >= NB) return false;
        u.e = bexp[u.pm]; return true;
    }
    __device__ __forceinline__ const char* aptr(const Unit& u) const { return A + (size_t)u.pm * BM * K * 2; }
    __device__ __forceinline__ const char* bptr(const Unit& u) const { return W + ((size_t)u.e * N + (size_t)u.pn * BM) * K * 2; }
    __device__ __forceinline__ void a_ready(const Unit&) const {}
    __device__ __forceinline__ void done(const Unit&) const {}
};
struct SchedMoeG {
    static constexpr bool GATHER = true;
    const char* A; const char* W; const PG8_LAS unsigned char* bexp; const PG8_LAS unsigned short* rt; int NB, K, nN, N, G, c;
    __device__ __forceinline__ bool next(int i, Unit& u) const {
        const int x = c & 7, q = i * (G >> 3) + (c >> 3), chunk = (NB + 7) >> 3, r = q / nN;
        u.pm = x * chunk + r; u.pn = q % nN; if (r >= chunk || u.pm >= NB) return false;
        u.e = bexp[u.pm]; return true;
    }
    __device__ __forceinline__ unsigned arow(int i, int r) const { return (unsigned)rt[i * 256 + r]; }
    __device__ __forceinline__ const char* aptr(const Unit&) const { return A; }
    __device__ __forceinline__ const char* bptr(const Unit& u) const { return W + ((size_t)u.e * N + (size_t)u.pn * BM) * K * 2; }
    __device__ __forceinline__ void a_ready(const Unit&) const {}
    __device__ __forceinline__ void done(const Unit&) const {}
};

__device__ __forceinline__ unsigned cvt_pk_bf16(float lo, float hi) { unsigned r; asm volatile("v_cvt_pk_bf16_f32 %0, %1, %2" : "=v"(r) : "v"(lo), "v"(hi)); return r; }

template <int ACT> struct EpiF32 {
    static constexpr bool PERM = false, AFTER_DRAIN = false;
    float* C; int ldc; size_t estride;
    __device__ __forceinline__ void operator()(const f32x4 (&acc)[2][2][4][2], const Unit& u, int wr, int wc, int fr, int fq) const {
        const int row0 = u.pm * BM + wr * 64 + fr, col0 = u.pn * BM + wc * 32 + 4 * fq;
        float* Cb = C + (size_t)u.e * estride;
#pragma unroll
        for (int ai = 0; ai < 2; ++ai)
#pragma unroll
            for (int m = 0; m < 4; ++m) { float* rowp = Cb + (size_t)(row0 + ai * HALF + m * 16) * ldc + col0;
#pragma unroll
                for (int bj = 0; bj < 2; ++bj)
#pragma unroll
                    for (int n = 0; n < 2; ++n) { f32x4 v = acc[ai][bj][m][n];
                        if (ACT == 1) { v[0] = gelu_tanh(v[0]); v[1] = gelu_tanh(v[1]); v[2] = gelu_tanh(v[2]); v[3] = gelu_tanh(v[3]); }
                        *(f32x4*)(rowp + bj * HALF + n * 16) = v; } }
    }
};
struct EpiDual {
    static constexpr bool PERM = false, AFTER_DRAIN = false;
    float* C; bf16_t* O; int ldc;
    __device__ __forceinline__ void operator()(const f32x4 (&acc)[2][2][4][2], const Unit& u, int wr, int wc, int fr, int fq) const {
        const int row0 = u.pm * BM + wr * 64 + fr, col0 = u.pn * BM + wc * 32 + 4 * fq;
#pragma unroll
        for (int ai = 0; ai < 2; ++ai)
#pragma unroll
            for (int m = 0; m < 4; ++m) { const size_t off = (size_t)(row0 + ai * HALF + m * 16) * ldc + col0;
#pragma unroll
                for (int bj = 0; bj < 2; ++bj)
#pragma unroll
                    for (int n = 0; n < 2; ++n) { const f32x4 v = acc[ai][bj][m][n];
                        if (C) *(f32x4*)(C + off + bj * HALF + n * 16) = v;
                        typedef unsigned u32x2 __attribute__((ext_vector_type(2))); u32x2 w; w.x = cvt_pk_bf16(v[0], v[1]); w.y = cvt_pk_bf16(v[2], v[3]);
                        *(u32x2*)(O + off + bj * HALF + n * 16) = w; } }
    }
};
struct EpiBf16P {
    static constexpr bool PERM = true, AFTER_DRAIN = false;
    bf16_t* O; int ldc;
    __device__ __forceinline__ void operator()(const f32x4 (&acc)[2][2][4][2], const Unit& u, int wr, int wc, int fr, int fq) const {
        const int row0 = u.pm * BM + wr * 64 + fr, col0 = u.pn * BM + wc * 32 + 8 * fq;
#pragma unroll
        for (int ai = 0; ai < 2; ++ai)
#pragma unroll
            for (int m = 0; m < 4; ++m) { bf16_t* rowp = O + (size_t)(row0 + ai * HALF + m * 16) * ldc + col0;
#pragma unroll
                for (int bj = 0; bj < 2; ++bj) { const f32x4 v0 = acc[ai][bj][m][0], v1 = acc[ai][bj][m][1];
                    u32x4 w; w.x = cvt_pk_bf16(v0[0], v0[1]); w.y = cvt_pk_bf16(v0[2], v0[3]); w.z = cvt_pk_bf16(v1[0], v1[1]); w.w = cvt_pk_bf16(v1[2], v1[3]);
                    *(u32x4*)(rowp + bj * HALF) = w; } }
    }
};
struct EpiBf16Gelu {
    static constexpr bool PERM = true, AFTER_DRAIN = false;
    bf16_t* O; int ldc; size_t estride;
    __device__ __forceinline__ void operator()(const f32x4 (&acc)[2][2][4][2], const Unit& u, int wr, int wc, int fr, int fq) const {
        const int row0 = u.pm * BM + wr * 64 + fr, col0 = u.pn * BM + wc * 32 + 8 * fq;
        bf16_t* Ob = O + (size_t)u.e * estride;
#pragma unroll
        for (int ai = 0; ai < 2; ++ai)
#pragma unroll
            for (int m = 0; m < 4; ++m) { bf16_t* rowp = Ob + (size_t)(row0 + ai * HALF + m * 16) * ldc + col0;
#pragma unroll
                for (int bj = 0; bj < 2; ++bj) { const f32x4 v0 = acc[ai][bj][m][0], v1 = acc[ai][bj][m][1];
                    u32x4 w; w.x = cvt_pk_bf16(gelu_tanh(v0[0]), gelu_tanh(v0[1])); w.y = cvt_pk_bf16(gelu_tanh(v0[2]), gelu_tanh(v0[3])); w.z = cvt_pk_bf16(gelu_tanh(v1[0]), gelu_tanh(v1[1])); w.w = cvt_pk_bf16(gelu_tanh(v1[2]), gelu_tanh(v1[3]));
                    *(u32x4*)(rowp + bj * HALF) = w; } }
    }
};
struct EpiResid {
    static constexpr bool PERM = true, AFTER_DRAIN = false;
    const bf16_t* X; bf16_t* Z; int ldc; float alpha;
    __device__ __forceinline__ void operator()(const f32x4 (&acc)[2][2][4][2], const Unit& u, int wr, int wc, int fr, int fq) const {
        const int row0 = u.pm * BM + wr * 64 + fr, col0 = u.pn * BM + wc * 32 + 8 * fq;
#pragma unroll
        for (int ai = 0; ai < 2; ++ai)
#pragma unroll
            for (int m = 0; m < 4; ++m) { const size_t off = (size_t)(row0 + ai * HALF + m * 16) * ldc + col0;
#pragma unroll
                for (int bj = 0; bj < 2; ++bj) { const u32x4 xr = *(const u32x4*)(X + off + bj * HALF);
                    const f32x4 x0 = {__builtin_bit_cast(float, xr.x << 16), __builtin_bit_cast(float, xr.x & 0xffff0000u), __builtin_bit_cast(float, xr.y << 16), __builtin_bit_cast(float, xr.y & 0xffff0000u)};
                    const f32x4 x1 = {__builtin_bit_cast(float, xr.z << 16), __builtin_bit_cast(float, xr.z & 0xffff0000u), __builtin_bit_cast(float, xr.w << 16), __builtin_bit_cast(float, xr.w & 0xffff0000u)};
                    const f32x4 v0 = x0 * alpha + acc[ai][bj][m][0], v1 = x1 * alpha + acc[ai][bj][m][1];
                    u32x4 w; w.x = cvt_pk_bf16(v0[0], v0[1]); w.y = cvt_pk_bf16(v0[2], v0[3]); w.z = cvt_pk_bf16(v1[0], v1[1]); w.w = cvt_pk_bf16(v1[2], v1[3]);
                    *(u32x4*)(Z + off + bj * HALF) = w; } }
    }
};
struct EpiSwiglu {
    static constexpr bool PERM = true, AFTER_DRAIN = false;
    bf16_t* O; const float* bias;
    __device__ __forceinline__ void operator()(const f32x4 (&acc)[2][2][4][2], const Unit& u, int wr, int wc, int fr, int fq) const {
        const int row0 = u.pm * BM + wr * 64 + fr, c0 = u.pn * HALF + wc * 32 + 8 * fq;
        const float* bg = bias + (size_t)u.e * 2048 + c0; const float* bl = bg + 1024;
        const f32x4 bg0 = *(const f32x4*)bg, bg1 = *(const f32x4*)(bg + 4), bl0 = *(const f32x4*)bl, bl1 = *(const f32x4*)(bl + 4);
#pragma unroll
        for (int ai = 0; ai < 2; ++ai)
#pragma unroll
            for (int m = 0; m < 4; ++m) {
                f32x4 g0 = acc[ai][0][m][0] + bg0, g1 = acc[ai][0][m][1] + bg1, l0 = acc[ai][1][m][0] + bl0, l1 = acc[ai][1][m][1] + bl1;
                float o[8];
#pragma unroll
                for (int j = 0; j < 4; ++j) {
                    float g = fminf(g0[j], 7.0f), l = fminf(fmaxf(l0[j], -7.0f), 7.0f); o[j] = g * __builtin_amdgcn_rcpf(1.0f + __builtin_amdgcn_exp2f(-2.4554669595930156f * g)) * (l + 1.0f);
                    g = fminf(g1[j], 7.0f); l = fminf(fmaxf(l1[j], -7.0f), 7.0f); o[4 + j] = g * __builtin_amdgcn_rcpf(1.0f + __builtin_amdgcn_exp2f(-2.4554669595930156f * g)) * (l + 1.0f); }
                u32x4 w; w.x = cvt_pk_bf16(o[0], o[1]); w.y = cvt_pk_bf16(o[2], o[3]); w.z = cvt_pk_bf16(o[4], o[5]); w.w = cvt_pk_bf16(o[6], o[7]);
                *(u32x4*)(O + (size_t)(row0 + ai * HALF + m * 16) * 1024 + c0) = w; }
    }
};
struct EpiDown {
    static constexpr bool PERM = true, AFTER_DRAIN = false;
    bf16_t* Y; const float* bias;
    __device__ __forceinline__ void operator()(const f32x4 (&acc)[2][2][4][2], const Unit& u, int wr, int wc, int fr, int fq) const {
        const int row0 = u.pm * BM + wr * 64 + fr, col0 = u.pn * BM + wc * 32 + 8 * fq;
        const float* bb = bias + (size_t)u.e * 1024 + col0;
        f32x4 bv[2][2];
#pragma unroll
        for (int bj = 0; bj < 2; ++bj)
#pragma unroll
            for (int n = 0; n < 2; ++n) bv[bj][n] = *(const f32x4*)(bb + bj * HALF + 4 * n);
#pragma unroll
        for (int ai = 0; ai < 2; ++ai)
#pragma unroll
            for (int m = 0; m < 4; ++m) { bf16_t* rowp = Y + (size_t)(row0 + ai * HALF + m * 16) * 1024 + col0;
#pragma unroll
                for (int bj = 0; bj < 2; ++bj) { const f32x4 v0 = acc[ai][bj][m][0] + bv[bj][0], v1 = acc[ai][bj][m][1] + bv[bj][1];
                    u32x4 w; w.x = cvt_pk_bf16(v0[0], v0[1]); w.y = cvt_pk_bf16(v0[2], v0[3]); w.z = cvt_pk_bf16(v1[0], v1[1]); w.w = cvt_pk_bf16(v1[2], v1[3]);
                    *(u32x4*)(rowp + bj * HALF) = w; } }
    }
};

template <class Epi, class Sched, bool ALIGN_EPI = false, bool SP2 = false>
__device__ __forceinline__ void gemm_phase(PG8_LAS unsigned char* lds, const int K, const Sched& S, const Epi& E, const int wave_id) {
    int lane_; { unsigned m_ = ~0u; asm volatile("" : "+s"(m_)); lane_ = (int)__builtin_amdgcn_mbcnt_hi(m_, __builtin_amdgcn_mbcnt_lo(m_, 0u)); }
    int wid_ = wave_id; asm volatile("" : "+s"(wid_));
    const int wid = wid_, lane = lane_, tid = wid * 64 + lane, wr = wid >> 2, wc = wid & 3, fr = lane & 15, fq = lane >> 4;
    const int nt = K / BK;
    unsigned voffA[2], voffB[2];
#pragma unroll
    for (int i = 0; i < 2; ++i) { int R, C; stage_rc(tid * 16 + i * 8192, R, C); const int Rb = Epi::PERM ? ((R & ~31) + perm32(R & 31)) : R;
        voffA[i] = (unsigned)(R * K + C) * 2u; voffB[i] = (unsigned)(Rb * K + C) * 2u; }
    unsigned gRC[2];
#pragma unroll
    for (int i = 0; i < 2; ++i) { int R, C; stage_rc(tid * 16 + i * 8192, R, C); gRC[i] = (unsigned)R | ((unsigned)C * 2u << 8); }
    unsigned vcur[2][2];
#define PG8_GOFF(dst, ui_) do { if constexpr (Sched::GATHER) { _Pragma("unroll") for (int h_ = 0; h_ < 2; ++h_) _Pragma("unroll") for (int i_ = 0; i_ < 2; ++i_) dst[h_][i_] = S.arow((ui_), h_ * HALF + (int)(gRC[i_] & 255u)) * (unsigned)(K * 2) + (gRC[i_] >> 8); } } while (0)
#define PG8_STAGEA(bufoff, base, h, VO) do { if constexpr (Sched::GATHER) { PG8_STAGE(bufoff, base, VO[h]); } else { PG8_STAGE(bufoff, (base) + (h) * hstep, voffA); } } while (0)
    const size_t kstep = (size_t)(BK * 2);
    const size_t hstep = (size_t)HALF * K * 2;
    const unsigned ldsw = (unsigned)wid * 1024u;
    const int aoff = lds_byte(wr * 64 + fr, fq * 8), boff = lds_byte(wc * 32 + fr, fq * 8);
#define PG8_SA(b, h) (((b) * 2 + (h)) * HTB)
#define PG8_SB(b, h) ((4 + (b) * 2 + (h)) * HTB)
#define PG8_STAGE(bufoff, gbase, voff) do { _Pragma("unroll") for (int _i = 0; _i < 2; ++_i) \
        __builtin_amdgcn_global_load_lds((const unsigned*)((const char*)(gbase) + (voff)[_i]), (PG8_LAS unsigned*)(lds + (bufoff) + ldsw + _i * 8192), 16, 0, 0); } while (0)
#define PG8_LDA(dst, b, h) do { _Pragma("unroll") for (int m = 0; m < 4; ++m) _Pragma("unroll") for (int k = 0; k < 2; ++k) dst[m][k] = *(const PG8_LAS bf16x8*)(lds + PG8_SA(b, h) + aoff + m * 2048 + k * 1024); } while (0)
#define PG8_LDB(dst, b, h) do { _Pragma("unroll") for (int n = 0; n < 2; ++n) _Pragma("unroll") for (int k = 0; k < 2; ++k) dst[n][k] = *(const PG8_LAS bf16x8*)(lds + PG8_SB(b, h) + boff + n * 2048 + k * 1024); } while (0)
#define PG8_MMA(ai, bj, At, Bt) do { __builtin_amdgcn_s_setprio(1); _Pragma("unroll") for (int m = 0; m < 4; ++m) _Pragma("unroll") for (int n = 0; n < 2; ++n) _Pragma("unroll") for (int k = 0; k < 2; ++k) \
        acc[ai][bj][m][n] = __builtin_amdgcn_mfma_f32_16x16x32_bf16(Bt[n][k], At[m][k], acc[ai][bj][m][n], 0, 0, 0); __builtin_amdgcn_s_setprio(0); } while (0)
#define PG8_WAIT_V(n) asm volatile("s_waitcnt vmcnt(" #n ")" ::: "memory")
#define PG8_WAIT_L(n) asm volatile("s_waitcnt lgkmcnt(" #n ")" ::: "memory")
#define PG8_BAR __builtin_amdgcn_s_barrier()
#define PG8_SCHED __builtin_amdgcn_sched_barrier(0)
    Unit cur, nxt; int ui = 0;
    if (!S.next(0, cur)) return;
    f32x4 acc[2][2][4][2];
#pragma unroll
    for (int a = 0; a < 2; ++a)
#pragma unroll
        for (int b = 0; b < 2; ++b)
#pragma unroll
            for (int m = 0; m < 4; ++m)
#pragma unroll
                for (int n = 0; n < 2; ++n) acc[a][b][m][n] = (f32x4){0.f, 0.f, 0.f, 0.f};
    bf16x8 At[4][2], B0[2][2], B1[2][2];
    const char* cA = S.aptr(cur); const char* cB = S.bptr(cur);
    S.a_ready(cur);
    PG8_GOFF(vcur, 0);
    if constexpr (SP2) {
        PG8_STAGE(PG8_SB(0, 0), cB, voffB); PG8_STAGE(PG8_SB(0, 1), cB + hstep, voffB); PG8_STAGEA(PG8_SA(0, 0), cA, 0, vcur); PG8_STAGEA(PG8_SA(0, 1), cA, 1, vcur);
        if (wr == 1) PG8_BAR;
        PG8_WAIT_V(2); PG8_BAR;
        PG8_STAGE(PG8_SB(1, 0), cB + kstep, voffB); PG8_STAGEA(PG8_SA(1, 0), cA + kstep, 0, vcur); PG8_STAGE(PG8_SB(1, 1), cB + hstep + kstep, voffB);
        PG8_WAIT_V(6); PG8_BAR;
    } else {
        PG8_STAGE(PG8_SB(0, 0), cB, voffB); PG8_STAGEA(PG8_SA(0, 0), cA, 0, vcur); PG8_STAGE(PG8_SB(0, 1), cB + hstep, voffB); PG8_STAGEA(PG8_SA(0, 1), cA, 1, vcur);
        if (wr == 1) PG8_BAR;
        PG8_WAIT_V(4); PG8_BAR;
        PG8_STAGE(PG8_SB(1, 0), cB + kstep, voffB); PG8_STAGEA(PG8_SA(1, 0), cA + kstep, 0, vcur); PG8_STAGE(PG8_SB(1, 1), cB + hstep + kstep, voffB);
        PG8_WAIT_V(6); PG8_BAR;
    }
    for (;;) {
        const bool has_next = S.next(ui + 1, nxt);
        const char* nA = has_next ? S.aptr(nxt) : cA; const char* nB = has_next ? S.bptr(nxt) : cB;
        for (int t = 0; t < nt; t += 2) {
            const bool last = (t == nt - 2);
            const char* a1 = cA + (size_t)(t + 1) * kstep;
            const char* a2 = last ? nA : cA + (size_t)(t + 2) * kstep; const char* b2 = last ? nB : cB + (size_t)(t + 2) * kstep;
            const char* a3 = a2 + kstep; const char* b3 = b2 + kstep;
            if (last && has_next) S.a_ready(nxt);
            if constexpr (SP2) {
            PG8_LDB(B0, 0, 0); PG8_LDB(B1, 0, 1); PG8_SCHED; PG8_LDA(At, 0, 0); PG8_STAGEA(PG8_SA(1, 1), a1, 1, vcur);
            if constexpr (Sched::GATHER) { if (last && has_next) PG8_GOFF(vcur, ui + 1); }
            PG8_WAIT_V(8); PG8_WAIT_L(0); PG8_BAR; PG8_MMA(0, 0, At, B0); PG8_MMA(0, 1, At, B1); PG8_BAR; PG8_SCHED;
            PG8_LDA(At, 0, 1); PG8_STAGE(PG8_SB(0, 0), b2, voffB); PG8_STAGE(PG8_SB(0, 1), b2 + hstep, voffB); PG8_STAGEA(PG8_SA(0, 0), a2, 0, vcur);
            PG8_WAIT_V(8); PG8_WAIT_L(0); PG8_BAR; PG8_MMA(1, 0, At, B0); PG8_MMA(1, 1, At, B1); PG8_BAR; PG8_SCHED;
            PG8_LDB(B0, 1, 0); PG8_LDB(B1, 1, 1); PG8_SCHED; PG8_LDA(At, 1, 0); PG8_STAGEA(PG8_SA(0, 1), a2, 1, vcur);
            PG8_WAIT_V(8); PG8_WAIT_L(0); PG8_BAR; PG8_MMA(0, 0, At, B0); PG8_MMA(0, 1, At, B1); PG8_BAR; PG8_SCHED;
            PG8_LDA(At, 1, 1); PG8_STAGE(PG8_SB(1, 0), b3, voffB); PG8_STAGE(PG8_SB(1, 1), b3 + hstep, voffB); PG8_STAGEA(PG8_SA(1, 0), a3, 0, vcur);
            PG8_WAIT_V(8); PG8_WAIT_L(0); PG8_BAR; PG8_MMA(1, 0, At, B0); PG8_MMA(1, 1, At, B1); PG8_BAR; PG8_SCHED;
            } else {
            PG8_LDB(B0, 0, 0); PG8_SCHED; PG8_LDA(At, 0, 0); PG8_STAGEA(PG8_SA(1, 1), a1, 1, vcur);
            PG8_WAIT_L(8); PG8_BAR; PG8_WAIT_L(0); PG8_MMA(0, 0, At, B0); PG8_BAR; PG8_SCHED;
            PG8_LDB(B1, 0, 1); PG8_STAGE(PG8_SB(0, 0), b2, voffB);
            PG8_BAR; PG8_WAIT_L(0); PG8_MMA(0, 1, At, B1); PG8_BAR;
            PG8_LDA(At, 0, 1); PG8_STAGEA(PG8_SA(0, 0), a2, 0, vcur);
            PG8_BAR; PG8_WAIT_L(0); PG8_MMA(1, 0, At, B0); PG8_BAR; PG8_SCHED;
            PG8_STAGE(PG8_SB(0, 1), b2 + hstep, voffB);
            PG8_WAIT_V(6); PG8_BAR; PG8_MMA(1, 1, At, B1); PG8_BAR;
            PG8_LDB(B0, 1, 0); PG8_SCHED; PG8_LDA(At, 1, 0); PG8_STAGEA(PG8_SA(0, 1), a2, 1, vcur);
            PG8_WAIT_L(8); PG8_BAR; PG8_WAIT_L(0); PG8_MMA(0, 0, At, B0); PG8_BAR; PG8_SCHED;
            PG8_LDB(B1, 1, 1); PG8_STAGE(PG8_SB(1, 0), b3, voffB);
            PG8_BAR; PG8_WAIT_L(0); PG8_MMA(0, 1, At, B1); PG8_BAR;
            PG8_LDA(At, 1, 1); PG8_STAGEA(PG8_SA(1, 0), a3, 0, vcur);
            PG8_BAR; PG8_WAIT_L(0); PG8_MMA(1, 0, At, B0); PG8_BAR; PG8_SCHED;
            PG8_STAGE(PG8_SB(1, 1), b3 + hstep, voffB);
            PG8_WAIT_V(6); PG8_BAR; PG8_MMA(1, 1, At, B1); PG8_BAR;
            }
        }
        if constexpr (ALIGN_EPI) { if (wr == 0) PG8_BAR; }
        if constexpr (!Epi::AFTER_DRAIN) { E(acc, cur, wr, wc, fr, fq); S.done(cur); }
        if (!has_next) break;
#pragma unroll
        for (int a = 0; a < 2; ++a)
#pragma unroll
            for (int b = 0; b < 2; ++b)
#pragma unroll
                for (int m = 0; m < 4; ++m)
#pragma unroll
                    for (int n = 0; n < 2; ++n) acc[a][b][m][n] = (f32x4){0.f, 0.f, 0.f, 0.f};
        cur = nxt; cA = nA; cB = nB; ++ui;
        if constexpr (ALIGN_EPI) { if (wr == 1) PG8_BAR; }
    }
    PG8_WAIT_V(0);
    if constexpr (!ALIGN_EPI) { if (wr == 0) PG8_BAR; }
    PG8_BAR;
    if constexpr (Epi::AFTER_DRAIN) { E.fused(acc, cur, wr, wc, fr, fq, lds, wid, lane); S.done(cur); }
#undef PG8_GOFF
#undef PG8_STAGEA
#undef PG8_SA
#undef PG8_SB
#undef PG8_STAGE
#undef PG8_LDA
#undef PG8_LDB
#undef PG8_MMA
#undef PG8_WAIT_V
#undef PG8_WAIT_L
#undef PG8_BAR
#undef PG8_SCHED
}
}

#define LAS __attribute__((address_space(3)))
DI int lane_now() { unsigned m = ~0u; asm volatile("" : "+s"(m)); return (int)__builtin_amdgcn_mbcnt_hi(m, __builtin_amdgcn_mbcnt_lo(m, 0u)); }
#define XB_TMO      128
#define XB_XCNT(j)  (256  + 64 * (j))
#define XB_XSUB(j)  (1280 + 64 * (j))
#define XB_XGEN(j)  (2304 + 64 * (j))
#define XB_TOP      3328
#define XB_TOPGEN   3392
#define XCD_BAR_WORDS 3456
#define XB_SPIN_CAP (1u << 18)
__device__ __forceinline__ unsigned xb_ld(unsigned* p)              { return __hip_atomic_load(p, __ATOMIC_RELAXED, __HIP_MEMORY_SCOPE_AGENT); }
__device__ __forceinline__ unsigned xb_add(unsigned* p, unsigned v) { return __hip_atomic_fetch_add(p, v, __ATOMIC_RELAXED, __HIP_MEMORY_SCOPE_AGENT); }
__device__ __forceinline__ unsigned xb_xcc_id() { return (unsigned)__builtin_amdgcn_s_getreg((3 << 11) | 20) & 0xFu; }
#define XB_SPIN(cond, bar) do { unsigned _sp = 0; while (cond) { __builtin_amdgcn_s_sleep(1); \
    if ((++_sp & 255u) == 0u) { if (xb_ld(&(bar)[XB_TMO])) break; if (_sp > XB_SPIN_CAP) { atomicAdd(&(bar)[XB_TMO], 1u); break; } } } } while (0)
struct XcdBarrier { unsigned* bar; unsigned x; volatile LAS unsigned* st; int wave; };
__device__ __forceinline__ XcdBarrier xcd_barrier_post(unsigned* bar, volatile LAS unsigned* st) {
    XcdBarrier b; b.bar = bar; b.x = xb_xcc_id(); b.st = st;
    if (threadIdx.x == 0) (void)xb_add(&bar[XB_XCNT(b.x)], 1u);
    return b;
}
__device__ __forceinline__ void xcd_barrier_complete(unsigned* bar, unsigned x, unsigned& nloc, unsigned& nx) {
    const unsigned G = gridDim.x * gridDim.y * gridDim.z;
    unsigned sum, cnt, mine, sp = 0u;
    for (;;) {
        sum = 0u; cnt = 0u; mine = 0u;
#pragma unroll
        for (unsigned j = 0; j < 16; ++j) { const unsigned c = xb_ld(&bar[XB_XCNT(j)]); sum += c; cnt += (c > 0u) ? 1u : 0u; mine = (j == x) ? c : mine; }
        if (sum == G) break;
        __builtin_amdgcn_s_sleep(1);
        if ((++sp & 255u) == 0u) { if (xb_ld(&bar[XB_TMO])) break; if (sp > XB_SPIN_CAP) { atomicAdd(&bar[XB_TMO], 1u); break; } }
    }
    nloc = mine > 0u ? mine : 1u; nx = cnt > 0u ? cnt : 1u;
}
__device__ __forceinline__ void xcd_barrier(const XcdBarrier& b) {
    asm volatile("s_waitcnt vmcnt(0)" ::: "memory");
    __syncthreads();
    if (b.wave == 0 && lane_now() == 0) {
        unsigned* bar = b.bar;
        __builtin_amdgcn_s_waitcnt(0);
        unsigned nloc = b.st[0], nx = b.st[1];
        if (nloc == 0u) { xcd_barrier_complete(bar, b.x, nloc, nx); b.st[0] = nloc; b.st[1] = nx; }
        const unsigned old = xb_add(&bar[XB_XSUB(b.x)], 1u);
        const unsigned gen = old / nloc;
        if (old + 1u == (gen + 1u) * nloc) {
            __builtin_amdgcn_fence(__ATOMIC_RELEASE, "agent");
            asm volatile("s_waitcnt vmcnt(0)" ::: "memory");
            const unsigned og = xb_add(&bar[XB_TOP], 1u);
            const unsigned tg = og / nx;
            if (og + 1u == (tg + 1u) * nx) xb_add(&bar[XB_TOPGEN], 1u);
            else XB_SPIN(xb_ld(&bar[XB_TOPGEN]) == tg, bar);
            __builtin_amdgcn_fence(__ATOMIC_ACQUIRE, "agent");
            xb_add(&bar[XB_XGEN(b.x)], 1u);
            asm volatile("s_waitcnt vmcnt(0)" ::: "memory");
        } else {
            XB_SPIN(xb_ld(&bar[XB_XGEN(b.x)]) == gen, bar);
            __builtin_amdgcn_fence(__ATOMIC_ACQUIRE, "agent");
            asm volatile("s_waitcnt vmcnt(0)" ::: "memory");
        }
    }
    __syncthreads();
}

struct Args { const float* in[37]; float* out; unsigned char* ws; int ph_lo, ph_hi; int probe, pad; };
struct Frame {
    unsigned char* lds;
    unsigned char* ws;
    int tid, lane, wave, G, bid;
};
enum { I_X = 0, I_MEM, I_REL, I_NSA_WIN, I_NSA_GB, I_NSA_PE, I_NSA_W1, I_NSA_W2, I_GLA_WIN, I_GLA_WA2, I_GLA_BA, I_GLA_BOG, I_GLA_NW,
       I_RW_WIN, I_RW_MU, I_RW_W0, I_RW_W2, I_RW_A0, I_RW_A2, I_RW_G2, I_RW_KK, I_RW_KA, I_RW_RK, I_RW_LNW, I_RW_LNB,
       I_MEM_WKV, I_WOUT, I_LN1G, I_LN1B, I_LN2G, I_LN2B, I_RTW, I_RTB, I_WGU, I_BGU, I_WDN, I_BDN };

DI void enter(Frame& F) { int l = lane_now();
    F.lane = l; F.tid = F.wave * 64 + l;
    { int b_ = F.bid, g_ = F.G, w_ = F.wave; asm volatile("" : "+s"(b_), "+s"(g_), "+s"(w_)); F.bid = b_; F.G = g_; F.wave = w_; F.tid = w_ * 64 + l; }
    unsigned long long w = (unsigned long long)F.ws; asm volatile("" : "+s"(w));
    F.ws = (unsigned char*)(__attribute__((address_space(1))) unsigned char*)w; }
DI void transpose_item(const float* W, int K, int N, int nblk, bf16* WT, int mode, unsigned short* scr, int item, int lane) {
    const int grp = item >> 3, w8 = item & 7, ngn = nblk >> 1, kb = 4 * (grp / ngn) + (w8 >> 1), nb = 2 * (grp % ngn) + (w8 & 1), k0 = 64 * kb, n0 = 64 * nb;
    const int nn = n0 + 4 * (lane & 15);
    f32x4 v[16];
#pragma unroll
    for (int i = 0; i < 16; ++i) { const int kk = 4 * i + (lane >> 4); const float* src = W + (size_t)(k0 + kk) * N + nn;
        if (nn + 3 < N) v[i] = __builtin_nontemporal_load((const f32x4*)src);
        else { v[i][0] = nn < N ? src[0] : 0.f; v[i][1] = nn + 1 < N ? src[1] : 0.f; v[i][2] = nn + 2 < N ? src[2] : 0.f; v[i][3] = 0.f; } }
#pragma unroll
    for (int i = 0; i < 16; ++i) { const int kk = 4 * i + (lane >> 4); v2u o; o.x = pk2(v[i][0], v[i][1]); o.y = pk2(v[i][2], v[i][3]); *(v2u*)(scr + kk * 68 + 4 * (lane & 15)) = o; }
    asm volatile("s_waitcnt lgkmcnt(0)" ::: "memory");
    int d0 = n0;
    if (mode == 1) d0 = (n0 < 1024) ? 256 * (n0 >> 7) + (n0 & 127) : 256 * ((n0 - 1024) >> 7) + 128 + ((n0 - 1024) & 127);
    const int c = lane & 7;
#pragma unroll
    for (int j = 0; j < 8; ++j) { const int n = (lane >> 3) + 8 * j; const unsigned short* s = scr + (8 * c) * 68 + n;
        v4u o; o.x = (unsigned)s[0] | ((unsigned)s[68] << 16); o.y = (unsigned)s[2 * 68] | ((unsigned)s[3 * 68] << 16); o.z = (unsigned)s[4 * 68] | ((unsigned)s[5 * 68] << 16); o.w = (unsigned)s[6 * 68] | ((unsigned)s[7 * 68] << 16);
        *(v4u*)(WT + (size_t)(d0 + n) * K + k0 + 8 * c) = o; }
    asm volatile("s_waitcnt lgkmcnt(0)" ::: "memory");
}
DI void phase_prologue(const Args& a, Frame& F) {
    enter(F);
    unsigned short* scr = (unsigned short*)(F.lds + F.wave * 8704);
    const int gw = F.bid * 8 + F.wave, NGW = F.G * 8;
    constexpr int I_IN = 16 * 44, I_OUT = 16 * 16, I_KV = 16 * 8, I_C1 = 32 * 4, I_GU = 16 * 32, I_DN = 16 * 16;
    constexpr int N0 = 4 * I_IN, N1 = N0 + 4 * I_OUT, N2 = N1 + 4 * I_KV, N3 = N2 + 4 * I_C1, N4 = N3 + 128 * I_GU, N5 = N4 + 128 * I_DN;
    for (int it = gw; it < N5; it += NGW) {
        if (it < N0) { const int L = it / I_IN, r = it % I_IN, kind = L % 3, j = L / 3;
            const int cols = kind == 0 ? NSA_COLS : kind == 1 ? GLA_COLS : RWKV_COLS;
            const float* W = (kind == 0 ? a.in[I_NSA_WIN] : kind == 1 ? a.in[I_GLA_WIN] : a.in[I_RW_WIN]) + (size_t)j * D * cols;
            transpose_item(W, D, cols, 44, (bf16*)(F.ws + WS_WIN + (size_t)L * WIN_STRIDE), 0, scr, r, F.lane); }
        else if (it < N1) { const int q = it - N0, L = q / I_OUT, r = q % I_OUT;
            transpose_item(a.in[I_WOUT] + (size_t)L * D * D, D, D, 16, (bf16*)(F.ws + WS_WOUT) + (size_t)L * D * D, 0, scr, r, F.lane); }
        else if (it < N2) { const int q = it - N1, L = q / I_KV, r = q % I_KV;
            transpose_item(a.in[I_MEM_WKV] + (size_t)L * D * 512, D, 512, 8, (bf16*)(F.ws + WS_WKV) + (size_t)L * 512 * D, 0, scr, r, F.lane); }
        else if (it < N3) { const int q = it - N2, L = q / I_C1, r = q % I_C1;
            transpose_item(a.in[I_NSA_W1] + (size_t)L * 2048 * 256, 2048, 256, 4, (bf16*)(F.ws + WS_CW1) + (size_t)L * 256 * 2048, 0, scr, r, F.lane); }
        else if (it < N4) { const int q = it - N3, L = q / I_GU, r = q % I_GU;
            transpose_item(a.in[I_WGU] + (size_t)L * D * 2048, D, 2048, 32, (bf16*)(F.ws + WS_WGU) + (size_t)L * 2048 * D, 1, scr, r, F.lane); }
        else { const int q = it - N4, L = q / I_DN, r = q % I_DN;
            transpose_item(a.in[I_WDN] + (size_t)L * D * D, D, D, 16, (bf16*)(F.ws + WS_WDN) + (size_t)L * D * D, 0, scr, r, F.lane); }
    }
    { bf16* WL = (bf16*)(F.ws + 42 * MiB); const float* w2 = a.in[I_RW_W2], *a2 = a.in[I_RW_A2], *g2 = a.in[I_RW_G2];
      for (int blk = F.bid; blk < 2304 * 256 / 512; blk += F.G) { const int i = blk * 512 + F.tid; const int k = i & 255, n = i >> 8; float v = 0.f;
          if (n < 768) { if (k < 64) v = w2[k * 768 + n]; } else if (n < 1536) { if (k >= 64 && k < 128) v = a2[(k - 64) * 768 + (n - 768)]; } else { if (k >= 128) v = g2[(k - 128) * 768 + (n - 1536)]; }
          WL[i] = (bf16)f2bf(v); } }
    { bf16* W2T = (bf16*)(F.ws + WS_CW2T); const float* w2 = a.in[I_NSA_W2];
      for (int blk = F.bid; blk < 4 * 64 * 256 / 512; blk += F.G) { const int i = blk * 512 + F.tid; const int k = i & 255, dd = (i >> 8) & 63, m = i >> 14; W2T[i] = (bf16)f2bf(w2[((size_t)m * 256 + k) * 64 + dd]); } }
    const f32x4* x4 = (const f32x4*)a.in[I_X]; v2u* xb = (v2u*)(F.ws + WS_XB);
    for (int blk = F.bid; blk < T * D / 4 / 512 / 8; blk += F.G) {
        f32x4 v[8];
#pragma unroll
        for (int q = 0; q < 8; ++q) v[q] = __builtin_nontemporal_load(x4 + ((size_t)blk * 8 + q) * 512 + F.tid);
#pragma unroll
        for (int q = 0; q < 8; ++q) { v2u o; o.x = pk2(v[q][0], v[q][1]); o.y = pk2(v[q][2], v[q][3]); xb[((size_t)blk * 8 + q) * 512 + F.tid] = o; } }
    const f32x4* m4 = (const f32x4*)a.in[I_MEM]; v2u* mb = (v2u*)(F.ws + WS_MEMB);
    for (int blk = F.bid; blk < BATCH * MEMLEN * D / 4 / 512; blk += F.G) { const size_t i = (size_t)blk * 512 + F.tid; const f32x4 v = m4[i]; v2u o; o.x = pk2(v[0], v[1]); o.y = pk2(v[2], v[3]); mb[i] = o; }
}


typedef short bf16x8 __attribute__((ext_vector_type(8)));
typedef short s16x4 __attribute__((ext_vector_type(4)));
typedef float f32x16 __attribute__((ext_vector_type(16)));
typedef __bf16 bf16x2_t __attribute__((ext_vector_type(2)));
typedef short v4i16_t __attribute__((ext_vector_type(4)));
constexpr float LOG2E = 1.4426950408889634f;
constexpr int KVP = 144;
constexpr int KVTILE = 64 * KVP;
DI int crow(int r, int hi) { return (r & 3) + 8 * (r >> 2) + 4 * hi; }
DI unsigned cvtpk(float lo, float hi) { f32x2 v = {lo, hi}; bf16x2_t b = __builtin_convertvector(v, bf16x2_t); return __builtin_bit_cast(unsigned, b); }
DI s16x4 vtr(const unsigned char* p) { return __builtin_bit_cast(s16x4, __builtin_amdgcn_ds_read_tr16_b64_v4i16((LAS v4i16_t*)(LAS unsigned char*)p)); }
DI float xhalf(float v) { return __shfl_xor(v, 32); }
DI float xmax_half(float v) { const unsigned b = __builtin_bit_cast(unsigned, v); const auto r = __builtin_amdgcn_permlane32_swap(b, b, false, false);
    return fmaxf(__builtin_bit_cast(float, (unsigned)r[0]), __builtin_bit_cast(float, (unsigned)r[1])); }
DI float xsum_half(float v) { const unsigned b = __builtin_bit_cast(unsigned, v); const auto r = __builtin_amdgcn_permlane32_swap(b, b, false, false);
    return __builtin_bit_cast(float, (unsigned)r[0]) + __builtin_bit_cast(float, (unsigned)r[1]); }

DI bf16x8 frag_row(const unsigned char* base, int pitch, int row, int col) { return *(const bf16x8*)(base + row * pitch + col * 2); }
DI bf16x8 frag_col8(const unsigned char* base, int pitch, int r0, int c0, int lane) {
    const unsigned char* p = base + (r0 + ((lane & 15) >> 2)) * pitch + (c0 + ((lane >> 4) & 1) * 16 + (lane & 3) * 4) * 2;
    const s16x4 a = vtr(p), b = vtr(p + 4 * pitch);
    return (bf16x8){a[0], a[1], a[2], a[3], b[0], b[1], b[2], b[3]};
}
DI bf16x8 frag_col44(const unsigned char* base, int pitch, int r0, int c0, int lane) {
    const unsigned char* p = base + (r0 + ((lane & 15) >> 2)) * pitch + (c0 + ((lane >> 4) & 1) * 16 + (lane & 3) * 4) * 2;
    const s16x4 a = vtr(p), b = vtr(p + 8 * pitch);
    return (bf16x8){a[0], a[1], a[2], a[3], b[0], b[1], b[2], b[3]};
}
DI bf16x8 pack_acc(const f32x16& x, int s) {
    v4u w; w.x = cvtpk(x[8 * s], x[8 * s + 1]); w.y = cvtpk(x[8 * s + 2], x[8 * s + 3]); w.z = cvtpk(x[8 * s + 4], x[8 * s + 5]); w.w = cvtpk(x[8 * s + 6], x[8 * s + 7]);
    return __builtin_bit_cast(bf16x8, w);
}
#define MFMA32(a, b, c) __builtin_amdgcn_mfma_f32_32x32x16_bf16((a), (b), (c), 0, 0, 0)

struct AttnAcc { f32x16 o0, o1; float m, l; };
DI void attn_init(AttnAcc& A) {
#pragma unroll
    for (int i = 0; i < 16; ++i) { A.o0[i] = 0.f; A.o1[i] = 0.f; }
    A.m = -1e30f; A.l = 0.f;
}
struct KVRegs { v4u k, v; };
DI void kv_load(KVRegs& R, const bf16* Kg, const bf16* Vg, size_t ld, int tid) {
    const int row = tid >> 3, ch = tid & 7;
    R.k = *(const v4u*)(Kg + (size_t)row * ld + ch * 8); R.v = *(const v4u*)(Vg + (size_t)row * ld + ch * 8);
}
DI void kv_store(const KVRegs& R, unsigned char* Kl, unsigned char* Vl, int tid) {
    const int row = tid >> 3, ch = tid & 7;
    *(v4u*)(Kl + row * KVP + ch * 16) = R.k; *(v4u*)(Vl + row * KVP + ch * 16) = R.v;
}
constexpr int SWTILE = 8192;
template <bool SWZ> DI const unsigned char* kfrag_addr(const unsigned char* base, int row, int dc, int hi) {
    return SWZ ? base + row * 128 + (((2 * dc + hi) ^ (row & 7)) << 4) : base + row * KVP + dc * 32 + hi * 16;
}
template <bool SWZ> DI const unsigned char* vtr_addr(const unsigned char* base, int ks, int d0, int lane) {
    const int hi = lane >> 5, q = (lane & 15) >> 2, rowq = 4 * hi + q, row = 16 * ks + rowq;
    if (SWZ) { const int chunk = 4 * d0 + 2 * ((lane >> 4) & 1) + ((lane & 3) >> 1); return base + row * 128 + ((chunk ^ rowq) << 4) + (lane & 1) * 8; }
    return base + row * KVP + (d0 * 32 + ((lane >> 4) & 1) * 16 + (lane & 3) * 4) * 2;
}
DI void kv_dma(const bf16* Kg, const bf16* Vg, size_t ld, unsigned char* Kl, unsigned char* Vl, int wave, int lane) {
    const int row = 8 * wave + (lane >> 3), ch = (lane & 7) ^ (lane >> 3);
    __builtin_amdgcn_global_load_lds((const unsigned*)(Kg + (size_t)row * ld + ch * 8), (LAS unsigned*)(LAS unsigned char*)(Kl + wave * 1024), 16, 0, 0);
    __builtin_amdgcn_global_load_lds((const unsigned*)(Vg + (size_t)row * ld + ch * 8), (LAS unsigned*)(LAS unsigned char*)(Vl + wave * 1024), 16, 0, 0);
}
DI void vtr16_asm(s16x4 (&o)[16], unsigned a0, unsigned a1) {
    asm volatile(
        "ds_read_b64_tr_b16 %0, %16\n\tds_read_b64_tr_b16 %1, %16 offset:1024\n\tds_read_b64_tr_b16 %2, %17\n\tds_read_b64_tr_b16 %3, %17 offset:1024\n\t"
        "ds_read_b64_tr_b16 %4, %16 offset:2048\n\tds_read_b64_tr_b16 %5, %16 offset:3072\n\tds_read_b64_tr_b16 %6, %17 offset:2048\n\tds_read_b64_tr_b16 %7, %17 offset:3072\n\t"
        "ds_read_b64_tr_b16 %8, %16 offset:4096\n\tds_read_b64_tr_b16 %9, %16 offset:5120\n\tds_read_b64_tr_b16 %10, %17 offset:4096\n\tds_read_b64_tr_b16 %11, %17 offset:5120\n\t"
        "ds_read_b64_tr_b16 %12, %16 offset:6144\n\tds_read_b64_tr_b16 %13, %16 offset:7168\n\tds_read_b64_tr_b16 %14, %17 offset:6144\n\tds_read_b64_tr_b16 %15, %17 offset:7168\n\t"
        "s_waitcnt lgkmcnt(0)"
        : "=&v"(o[0]), "=&v"(o[1]), "=&v"(o[2]), "=&v"(o[3]), "=&v"(o[4]), "=&v"(o[5]), "=&v"(o[6]), "=&v"(o[7]),
          "=&v"(o[8]), "=&v"(o[9]), "=&v"(o[10]), "=&v"(o[11]), "=&v"(o[12]), "=&v"(o[13]), "=&v"(o[14]), "=&v"(o[15])
        : "v"(a0), "v"(a1) : "memory");
}
DI unsigned lds_addr(const unsigned char* p) { return (unsigned)(uintptr_t)p; }
template <bool GENERAL, bool NOBIAS, bool SWZ = false>
DI void attn_tile(const unsigned char* Kl, const unsigned char* Vl, const bf16x8 (&qf)[4], AttnAcc& A, int lane, bool en, int dq, int lim, const float* btab, float cfar) {
    const int r32 = lane & 31, hi = lane >> 5;
    f32x16 p0, p1;
#pragma unroll
    for (int i = 0; i < 16; ++i) { p0[i] = 0.f; p1[i] = 0.f; }
#pragma unroll
    for (int dc = 0; dc < 4; ++dc) {
        const bf16x8 k0 = *(const bf16x8*)kfrag_addr<SWZ>(Kl, r32, dc, hi), k1 = *(const bf16x8*)kfrag_addr<SWZ>(Kl, r32 + 32, dc, hi);
        p0 = __builtin_amdgcn_mfma_f32_32x32x16_bf16(k0, qf[dc], p0, 0, 0, 0);
        p1 = __builtin_amdgcn_mfma_f32_32x32x16_bf16(k1, qf[dc], p1, 0, 0, 0);
    }
    const float NEG = -1e30f;
    float mx;
    float cl = 0.f;
    if (GENERAL) {
        const float ce = en ? 0.f : NEG;
        int dqh = dq - 4 * hi; asm volatile("" : "+v"(dqh));
        if (lim == 1) {
            const float* rb = btab + (191 - dqh);
#pragma unroll
            for (int r = 0; r < 16; ++r) { const int o = (r & 3) + 8 * (r >> 2); p0[r] = p0[r] * LOG2E + (rb[o] + ce); p1[r] = p1[r] * LOG2E + (rb[32 + o] + ce); }
        } else if (lim == 2) {
            const float* rb = btab + (191 - dqh);
#pragma unroll
            for (int r = 0; r < 16; ++r) { const int o = (r & 3) + 8 * (r >> 2);
                p0[r] = (o <= dqh) ? p0[r] * LOG2E + (rb[o] + ce) : NEG; p1[r] = (o + 32 <= dqh) ? p1[r] * LOG2E + (rb[32 + o] + ce) : NEG; }
        } else {
            const int kmin = dqh - 512; const float cb = cfar + ce;
#pragma unroll
            for (int r = 0; r < 16; ++r) { const int o = (r & 3) + 8 * (r >> 2);
                p0[r] = (o > kmin) ? p0[r] * LOG2E + cb : NEG; p1[r] = (o + 32 > kmin) ? p1[r] * LOG2E + cb : NEG; }
        }
        mx = fmaxf(p0[0], p1[0]);
#pragma unroll
        for (int r = 1; r < 16; ++r) mx = fmaxf(fmaxf(mx, p0[r]), p1[r]);
    } else {
        float pm = fmaxf(p0[0], p1[0]);
#pragma unroll
        for (int r = 1; r < 16; ++r) pm = fmaxf(fmaxf(pm, p0[r]), p1[r]);
        cl = NOBIAS ? 0.f : (en ? cfar : NEG);
        mx = pm * LOG2E + cl;
    }
    mx = xmax_half(mx);
    const float mn = fmaxf(A.m, mx);
    if (__any(mn > A.m)) {
        const float alpha = __builtin_amdgcn_exp2f(A.m - mn);
        A.l *= alpha;
#pragma unroll
        for (int r = 0; r < 16; ++r) { A.o0[r] *= alpha; A.o1[r] *= alpha; }
        A.m = mn;
    }
    float rs = 0.f;
    if (GENERAL) {
#pragma unroll
        for (int r = 0; r < 16; ++r) { p0[r] = __builtin_amdgcn_exp2f(p0[r] - mn); p1[r] = __builtin_amdgcn_exp2f(p1[r] - mn); rs += p0[r] + p1[r]; }
    } else {
        const float c2 = cl - mn;
#pragma unroll
        for (int r = 0; r < 16; ++r) { p0[r] = __builtin_amdgcn_exp2f(p0[r] * LOG2E + c2); p1[r] = __builtin_amdgcn_exp2f(p1[r] * LOG2E + c2); rs += p0[r] + p1[r]; }
    }
    A.l += rs;
    bf16x8 pa[4];
#pragma unroll
    for (int s = 0; s < 2; ++s) {
        v4u w0, w1;
        w0.x = cvtpk(p0[8 * s], p0[8 * s + 1]); w0.y = cvtpk(p0[8 * s + 2], p0[8 * s + 3]); w0.z = cvtpk(p0[8 * s + 4], p0[8 * s + 5]); w0.w = cvtpk(p0[8 * s + 6], p0[8 * s + 7]);
        w1.x = cvtpk(p1[8 * s], p1[8 * s + 1]); w1.y = cvtpk(p1[8 * s + 2], p1[8 * s + 3]); w1.z = cvtpk(p1[8 * s + 4], p1[8 * s + 5]); w1.w = cvtpk(p1[8 * s + 6], p1[8 * s + 7]);
        pa[s] = __builtin_bit_cast(bf16x8, w0); pa[2 + s] = __builtin_bit_cast(bf16x8, w1);
    }
    if constexpr (SWZ) {
        s16x4 vv[16]; vtr16_asm(vv, lds_addr(vtr_addr<true>(Vl, 0, 0, lane)), lds_addr(vtr_addr<true>(Vl, 0, 1, lane)));
#pragma unroll
        for (int ks = 0; ks < 4; ++ks) {
            const bf16x8 v0 = {vv[4 * ks][0], vv[4 * ks][1], vv[4 * ks][2], vv[4 * ks][3], vv[4 * ks + 1][0], vv[4 * ks + 1][1], vv[4 * ks + 1][2], vv[4 * ks + 1][3]};
            const bf16x8 v1 = {vv[4 * ks + 2][0], vv[4 * ks + 2][1], vv[4 * ks + 2][2], vv[4 * ks + 2][3], vv[4 * ks + 3][0], vv[4 * ks + 3][1], vv[4 * ks + 3][2], vv[4 * ks + 3][3]};
            A.o0 = __builtin_amdgcn_mfma_f32_32x32x16_bf16(v0, pa[ks], A.o0, 0, 0, 0);
            A.o1 = __builtin_amdgcn_mfma_f32_32x32x16_bf16(v1, pa[ks], A.o1, 0, 0, 0);
        }
    } else {
#pragma unroll
        for (int ks = 0; ks < 4; ++ks) {
            const unsigned char* v0p = vtr_addr<false>(Vl, ks, 0, lane); const unsigned char* v1p = vtr_addr<false>(Vl, ks, 1, lane); constexpr int R8 = 8 * KVP;
            const s16x4 a0l = vtr(v0p), a0h = vtr(v0p + R8), a1l = vtr(v1p), a1h = vtr(v1p + R8);
            const bf16x8 v0 = {a0l[0], a0l[1], a0l[2], a0l[3], a0h[0], a0h[1], a0h[2], a0h[3]};
            const bf16x8 v1 = {a1l[0], a1l[1], a1l[2], a1l[3], a1h[0], a1h[1], a1h[2], a1h[3]};
            A.o0 = __builtin_amdgcn_mfma_f32_32x32x16_bf16(v0, pa[ks], A.o0, 0, 0, 0);
            A.o1 = __builtin_amdgcn_mfma_f32_32x32x16_bf16(v1, pa[ks], A.o1, 0, 0, 0);
        }
    }
}
template <bool SWZ = false>
DI void attn_tile2(const unsigned char* Ka, const unsigned char* Va, const unsigned char* Kb, const unsigned char* Vb, const bf16x8 (&qf)[4], AttnAcc& A, int lane, float ca, float cb) {
    const int r32 = lane & 31, hi = lane >> 5;
    f32x16 p0, p1, p2, p3;
#pragma unroll
    for (int i = 0; i < 16; ++i) { p0[i] = 0.f; p1[i] = 0.f; p2[i] = 0.f; p3[i] = 0.f; }
    if constexpr (SWZ) __builtin_amdgcn_s_setprio(1);
#pragma unroll
    for (int dc = 0; dc < 4; ++dc) {
        p0 = MFMA32(*(const bf16x8*)kfrag_addr<SWZ>(Ka, r32, dc, hi), qf[dc], p0); p1 = MFMA32(*(const bf16x8*)kfrag_addr<SWZ>(Ka, r32 + 32, dc, hi), qf[dc], p1);
        p2 = MFMA32(*(const bf16x8*)kfrag_addr<SWZ>(Kb, r32, dc, hi), qf[dc], p2); p3 = MFMA32(*(const bf16x8*)kfrag_addr<SWZ>(Kb, r32 + 32, dc, hi), qf[dc], p3);
    }
    if constexpr (SWZ) __builtin_amdgcn_s_setprio(0);
    float ma = fmaxf(p0[0], p1[0]), mb = fmaxf(p2[0], p3[0]);
#pragma unroll
    for (int r = 1; r < 16; ++r) { ma = fmaxf(fmaxf(ma, p0[r]), p1[r]); mb = fmaxf(fmaxf(mb, p2[r]), p3[r]); }
    float mx = fmaxf(ma * LOG2E + ca, mb * LOG2E + cb);
    mx = xmax_half(mx);
    const float mn = fmaxf(A.m, mx);
    if (__any(mn > A.m)) {
        const float alpha = __builtin_amdgcn_exp2f(A.m - mn);
        A.l *= alpha;
#pragma unroll
        for (int r = 0; r < 16; ++r) { A.o0[r] *= alpha; A.o1[r] *= alpha; }
        A.m = mn;
    }
    const float c2a = ca - mn, c2b = cb - mn; float rs = 0.f;
#pragma unroll
    for (int r = 0; r < 16; ++r) { p0[r] = __builtin_amdgcn_exp2f(p0[r] * LOG2E + c2a); p1[r] = __builtin_amdgcn_exp2f(p1[r] * LOG2E + c2a);
        p2[r] = __builtin_amdgcn_exp2f(p2[r] * LOG2E + c2b); p3[r] = __builtin_amdgcn_exp2f(p3[r] * LOG2E + c2b); rs += (p0[r] + p1[r]) + (p2[r] + p3[r]); }
    A.l += rs;
    if constexpr (SWZ) {
        s16x4 vv[16];
        __builtin_amdgcn_s_setprio(1);
        vtr16_asm(vv, lds_addr(vtr_addr<true>(Va, 0, 0, lane)), lds_addr(vtr_addr<true>(Va, 0, 1, lane)));
#pragma unroll
        for (int ks = 0; ks < 4; ++ks) { const bf16x8 pa = pack_acc(ks < 2 ? p0 : p1, ks & 1);
            A.o0 = MFMA32(((bf16x8){vv[4 * ks][0], vv[4 * ks][1], vv[4 * ks][2], vv[4 * ks][3], vv[4 * ks + 1][0], vv[4 * ks + 1][1], vv[4 * ks + 1][2], vv[4 * ks + 1][3]}), pa, A.o0);
            A.o1 = MFMA32(((bf16x8){vv[4 * ks + 2][0], vv[4 * ks + 2][1], vv[4 * ks + 2][2], vv[4 * ks + 2][3], vv[4 * ks + 3][0], vv[4 * ks + 3][1], vv[4 * ks + 3][2], vv[4 * ks + 3][3]}), pa, A.o1); }
        vtr16_asm(vv, lds_addr(vtr_addr<true>(Vb, 0, 0, lane)), lds_addr(vtr_addr<true>(Vb, 0, 1, lane)));
#pragma unroll
        for (int ks = 0; ks < 4; ++ks) { const bf16x8 pb = pack_acc(ks < 2 ? p2 : p3, ks & 1);
            A.o0 = MFMA32(((bf16x8){vv[4 * ks][0], vv[4 * ks][1], vv[4 * ks][2], vv[4 * ks][3], vv[4 * ks + 1][0], vv[4 * ks + 1][1], vv[4 * ks + 1][2], vv[4 * ks + 1][3]}), pb, A.o0);
            A.o1 = MFMA32(((bf16x8){vv[4 * ks + 2][0], vv[4 * ks + 2][1], vv[4 * ks + 2][2], vv[4 * ks + 2][3], vv[4 * ks + 3][0], vv[4 * ks + 3][1], vv[4 * ks + 3][2], vv[4 * ks + 3][3]}), pb, A.o1); }
        __builtin_amdgcn_s_setprio(0);
    } else {
#pragma unroll
        for (int ks = 0; ks < 4; ++ks) {
            const bf16x8 pa = pack_acc(ks < 2 ? p0 : p1, ks & 1), pb = pack_acc(ks < 2 ? p2 : p3, ks & 1);
            constexpr int R8 = 8 * KVP;
            const unsigned char* va0 = vtr_addr<false>(Va, ks, 0, lane); const unsigned char* va1 = vtr_addr<false>(Va, ks, 1, lane);
            const unsigned char* vb0 = vtr_addr<false>(Vb, ks, 0, lane); const unsigned char* vb1 = vtr_addr<false>(Vb, ks, 1, lane);
            const s16x4 a0l = vtr(va0), a0h = vtr(va0 + R8), a1l = vtr(va1), a1h = vtr(va1 + R8);
            const s16x4 b0l = vtr(vb0), b0h = vtr(vb0 + R8), b1l = vtr(vb1), b1h = vtr(vb1 + R8);
            A.o0 = MFMA32(((bf16x8){a0l[0], a0l[1], a0l[2], a0l[3], a0h[0], a0h[1], a0h[2], a0h[3]}), pa, A.o0);
            A.o1 = MFMA32(((bf16x8){a1l[0], a1l[1], a1l[2], a1l[3], a1h[0], a1h[1], a1h[2], a1h[3]}), pa, A.o1);
            A.o0 = MFMA32(((bf16x8){b0l[0], b0l[1], b0l[2], b0l[3], b0h[0], b0h[1], b0h[2], b0h[3]}), pb, A.o0);
            A.o1 = MFMA32(((bf16x8){b1l[0], b1l[1], b1l[2], b1l[3], b1h[0], b1h[1], b1h[2], b1h[3]}), pb, A.o1);
        }
    }
}
DI void attn_finish(AttnAcc& A) {
    const float lt = xsum_half(A.l); const float inv = 1.0f / fmaxf(lt, 1e-30f);
#pragma unroll
    for (int r = 0; r < 16; ++r) { A.o0[r] *= inv; A.o1[r] *= inv; }
}
DI void load_q(bf16x8 (&qf)[4], const bf16* qrow, int hi) {
#pragma unroll
    for (int dc = 0; dc < 4; ++dc) { const v4u raw = *(const v4u*)(qrow + dc * 16 + hi * 8); v4u o;
        o.x = cvtpk(bf2f((unsigned short)(raw.x & 0xffff)) * 0.125f, bf2f((unsigned short)(raw.x >> 16)) * 0.125f);
        o.y = cvtpk(bf2f((unsigned short)(raw.y & 0xffff)) * 0.125f, bf2f((unsigned short)(raw.y >> 16)) * 0.125f);
        o.z = cvtpk(bf2f((unsigned short)(raw.z & 0xffff)) * 0.125f, bf2f((unsigned short)(raw.z >> 16)) * 0.125f);
        o.w = cvtpk(bf2f((unsigned short)(raw.w & 0xffff)) * 0.125f, bf2f((unsigned short)(raw.w >> 16)) * 0.125f);
        qf[dc] = __builtin_bit_cast(bf16x8, o); }
}

DI void phase_memattn_mfma(Frame& F, int qoff, int b0) {
    enter(F);
    const bf16* HB = (const bf16*)(F.ws + WS_HB); const bf16* KVB = (const bf16*)(F.ws + WS_KVB); bf16* CAT = (bf16*)(F.ws + WS_CAT);
    unsigned char* Kl = F.lds; unsigned char* Vl = F.lds + 4 * KVTILE;
    const int lane = F.lane, r32 = lane & 31, hi = lane >> 5;
    if (F.bid < b0) return;
    for (int u = F.bid - b0; u < BATCH * 4 * 16; u += F.G - b0) {
        const int b = u >> 6, head = (u >> 4) & 3, qt = u & 15;
        lds_barrier();
#pragma unroll
        for (int kt = 0; kt < 4; ++kt) { KVRegs R; const bf16* kg = KVB + (size_t)(b * 256 + kt * 64) * 512 + head * 64; kv_load(R, kg, kg + 256, 512, F.tid); kv_store(R, Kl + kt * KVTILE, Vl + kt * KVTILE, F.tid); }
        lds_barrier();
        const int t = b * SEQ + qt * 256 + F.wave * 32 + r32;
        bf16x8 qf[4]; load_q(qf, HB + (size_t)t * HC + qoff + head * 64, hi);
        AttnAcc A; attn_init(A);
#pragma unroll 1
        for (int kt = 0; kt < 4; kt += 2) attn_tile2(Kl + kt * KVTILE, Vl + kt * KVTILE, Kl + (kt + 1) * KVTILE, Vl + (kt + 1) * KVTILE, qf, A, lane, 0.f, 0.f);
        attn_finish(A);
        bf16* op = CAT + (size_t)t * D + TOKW + head * 64;
#pragma unroll
        for (int rq = 0; rq < 4; ++rq) { v2u w0, w1;
            w0.x = cvtpk(A.o0[4 * rq], A.o0[4 * rq + 1]); w0.y = cvtpk(A.o0[4 * rq + 2], A.o0[4 * rq + 3]);
            w1.x = cvtpk(A.o1[4 * rq], A.o1[4 * rq + 1]); w1.y = cvtpk(A.o1[4 * rq + 2], A.o1[4 * rq + 3]);
            *(v2u*)(op + 8 * rq + 4 * hi) = w0; *(v2u*)(op + 32 + 8 * rq + 4 * hi) = w1; }
    }
}

DI void phase_nsa_selwin_mfma(const Args& a, Frame& F, int j) {
    enter(F);
    const bf16* HB = (const bf16*)(F.ws + WS_HB); const float* OC = (const float*)(F.ws + MX_OC); float* OSB = (float*)(F.ws + MX_OSB);
    const unsigned long long* SELM = (const unsigned long long*)(F.ws + MX_SELM); bf16* CAT = (bf16*)(F.ws + WS_CAT);
    const float* rel = a.in[I_REL]; const float* gb = a.in[I_NSA_GB] + (size_t)j * 36;
    float* btab = (float*)(F.lds + 12 * SWTILE);
    const int lane = F.lane, r32 = lane & 31, hi = lane >> 5, w = F.wave;
    const int nunits = BATCH * 12 * 16;
    for (int it = 0;; ++it) {
        const int u0 = it * F.G + F.bid; if (u0 >= nunits) break;
        const int qraw = u0 & 15, bh = u0 >> 4, qt = (it & 1) ? 15 - qraw : qraw, b = bh / 12, hh = bh % 12, g = hh / 3;
        const int c0 = qt * 4, cw = c0 + (w >> 1), cmax = c0 + 3;
        const int tq = qt * 256 + w * 32 + r32, t = b * SEQ + tq;
        __syncthreads();
        { int tl = F.tid; asm volatile("" : "+v"(tl)); if (tl < 256) btab[tl] = tl <= 191 ? rel[t5_bucket(191 - tl) * 12 + hh] * LOG2E : 0.f; }
        const float cfar = rel[31 * 12 + hh] * LOG2E;
        bf16x8 qf[4]; load_q(qf, HB + (size_t)t * HC + NQ + hh * 64, hi);
        const unsigned long long sel = SELM[(size_t)t * 4 + g];
#pragma unroll 1
        for (int pp = 0; pp < 2 + ((a.probe >> 17) & 1) + ((a.probe >> 18) & 1); ++pp) {
            const int pass = ((a.probe >> 17) & 1) ? (pp <= 1 ? 0 : 1) : (pp == 0 ? 0 : 1);
            const bf16* Kg = HB + (size_t)(b * SEQ) * HC + (pass ? NKW : NKS) + g * 64; const bf16* Vg = HB + (size_t)(b * SEQ) * HC + (pass ? NVW : NVS) + g * 64;
            const int klo = pass ? (c0 >= 8 ? c0 - 8 : 0) : 0, ntile = cmax - klo + 1, npair = (ntile + 1) >> 1;
            AttnAcc A; attn_init(A);
#define SW_ISSUE(ip) do { const int kta_ = cmax - 2 * (ip), bq_ = (ip) % 3; unsigned char* kb_ = F.lds + bq_ * 4 * SWTILE; \
                kv_dma(Kg + (size_t)kta_ * 64 * HC, Vg + (size_t)kta_ * 64 * HC, HC, kb_, kb_ + 2 * SWTILE, w, lane); \
                if (kta_ - 1 >= klo) kv_dma(Kg + (size_t)(kta_ - 1) * 64 * HC, Vg + (size_t)(kta_ - 1) * 64 * HC, HC, kb_ + SWTILE, kb_ + 3 * SWTILE, w, lane); } while (0)
            asm volatile("s_waitcnt vmcnt(0) lgkmcnt(0)" ::: "memory"); __builtin_amdgcn_s_barrier();
            SW_ISSUE(0);
            if (npair > 1) { SW_ISSUE(1); if (cmax - 3 >= klo) asm volatile("s_waitcnt vmcnt(4)" ::: "memory"); else asm volatile("s_waitcnt vmcnt(2)" ::: "memory"); }
            else asm volatile("s_waitcnt vmcnt(0)" ::: "memory");
            __builtin_amdgcn_s_barrier();
#pragma unroll 1
            for (int i = 0; i < npair; ++i) {
                const int kt0 = cmax - 2 * i, kt1 = kt0 - 1; const bool has1 = kt1 >= klo;
                const int nahead = (i + 2 < npair) ? ((cmax - 2 * (i + 2) - 1 >= klo) ? 4 : 2) : 0;
                if (i + 2 < npair) SW_ISSUE(i + 2);
                const unsigned char* K0 = F.lds + (i % 3) * 4 * SWTILE; const unsigned char* K1 = K0 + SWTILE; const unsigned char* V0 = K0 + 2 * SWTILE; const unsigned char* V1 = K0 + 3 * SWTILE;
                const bool in0 = pass ? (kt0 <= cw && kt0 + 8 >= cw) : (kt0 <= cw);
                const bool in1 = has1 && (pass ? (kt1 <= cw && kt1 + 8 >= cw) : (kt1 <= cw));
                const bool en0 = pass ? true : (((sel >> kt0) & 1ull) != 0ull), en1 = pass ? true : (((sel >> (kt1 < 0 ? 0 : kt1)) & 1ull) != 0ull);
                const bool gen0 = (kt0 + 2 >= cw) || (pass && kt0 + 8 == cw), gen1 = (kt1 + 2 >= cw) || (pass && kt1 + 8 == cw);
                if (in0 && in1 && !gen0 && !gen1) {
                    if (__any(en0 || en1)) attn_tile2<true>(K0, V0, K1, V1, qf, A, lane, en0 ? cfar : -1e30f, en1 ? cfar : -1e30f);
                } else {
                    if (in0 && __any(en0)) { const int dq = tq - kt0 * 64;
                        if (gen0) attn_tile<true, false, true>(K0, V0, qf, A, lane, en0, dq, kt0 == cw ? 2 : (kt0 + 2 >= cw ? 1 : 3), btab, cfar);
                        else attn_tile<false, false, true>(K0, V0, qf, A, lane, en0, dq, 0, btab, cfar); }
                    if (in1 && __any(en1)) { const int dq = tq - kt1 * 64;
                        if (gen1) attn_tile<true, false, true>(K1, V1, qf, A, lane, en1, dq, kt1 == cw ? 2 : (kt1 + 2 >= cw ? 1 : 3), btab, cfar);
                        else attn_tile<false, false, true>(K1, V1, qf, A, lane, en1, dq, 0, btab, cfar); }
                }
                if (nahead == 4) asm volatile("s_waitcnt vmcnt(4) lgkmcnt(0)" ::: "memory"); else if (nahead == 2) asm volatile("s_waitcnt vmcnt(2) lgkmcnt(0)" ::: "memory"); else asm volatile("s_waitcnt vmcnt(0) lgkmcnt(0)" ::: "memory");
                __builtin_amdgcn_s_barrier();
            }
#undef SW_ISSUE
            attn_finish(A);
            if (pass == 0) {
                float* sp = OSB + (size_t)t * TOKW + hh * 64;
#pragma unroll
                for (int rq = 0; rq < 4; ++rq) { *(f32x4*)(sp + 8 * rq + 4 * hi) = (f32x4){A.o0[4 * rq], A.o0[4 * rq + 1], A.o0[4 * rq + 2], A.o0[4 * rq + 3]};
                    *(f32x4*)(sp + 32 + 8 * rq + 4 * hi) = (f32x4){A.o1[4 * rq], A.o1[4 * rq + 1], A.o1[4 * rq + 2], A.o1[4 * rq + 3]}; }
            } else {
                const bf16* glp = HB + (size_t)t * HC + NGL + hh * 3;
                const float g0 = fsigmoid(bf2f(glp[0]) + gb[hh * 3]), g1 = fsigmoid(bf2f(glp[1]) + gb[hh * 3 + 1]), g2 = fsigmoid(bf2f(glp[2]) + gb[hh * 3 + 2]);
                const float* oc = OC + (size_t)t * TOKW + hh * 64; const float* osp = OSB + (size_t)t * TOKW + hh * 64; bf16* op = CAT + (size_t)t * D + hh * 64;
#pragma unroll
                for (int rq = 0; rq < 4; ++rq) {
                    const f32x4 c0v = *(const f32x4*)(oc + 8 * rq + 4 * hi), c1v = *(const f32x4*)(oc + 32 + 8 * rq + 4 * hi);
                    const f32x4 s0v = *(const f32x4*)(osp + 8 * rq + 4 * hi), s1v = *(const f32x4*)(osp + 32 + 8 * rq + 4 * hi);
                    float v0[4], v1[4];
#pragma unroll
                    for (int e = 0; e < 4; ++e) { v0[e] = g0 * c0v[e] + g1 * s0v[e] + g2 * A.o0[4 * rq + e]; v1[e] = g0 * c1v[e] + g1 * s1v[e] + g2 * A.o1[4 * rq + e]; }
                    v2u w0, w1; w0.x = cvtpk(v0[0], v0[1]); w0.y = cvtpk(v0[2], v0[3]); w1.x = cvtpk(v1[0], v1[1]); w1.y = cvtpk(v1[2], v1[3]);
                    *(v2u*)(op + 8 * rq + 4 * hi) = w0; *(v2u*)(op + 32 + 8 * rq + 4 * hi) = w1;
                }
            }
        }
    }
}

DI void phase_nsa_cmpA(const Args& a, Frame& F, int j) {
    enter(F);
    const bf16* HB = (const bf16*)(F.ws + WS_HB); const float* pe = a.in[I_NSA_PE] + (size_t)j * 2 * 32 * 64;
    bf16* CA = (bf16*)(F.ws + MX_CMPA);
    for (int blk = F.bid; blk < 8192; blk += 4 * F.G) {
        v4u hr[4]; int rowv[4], c8v[4], whichv[4]; bool ok[4];
#pragma unroll
        for (int q = 0; q < 4; ++q) { const int bq = blk + q * F.G; const size_t i = (size_t)bq * 512 + F.tid;
            const int c8 = (int)(i & 255), row = (int)((i >> 8) & 8191), which = (int)(i >> 21);
            rowv[q] = row; c8v[q] = c8; whichv[q] = which; ok[q] = bq < 8192 && row < BATCH * NC * 4;
            if (ok[q]) { const int l = c8 >> 3, d = (c8 & 7) * 8, g = row & 3, bn = row >> 2, b = bn / NC, n = bn % NC;
                hr[q] = *(const v4u*)(HB + (size_t)(b * SEQ + 16 * n + l) * HC + (which ? NVC : NKC) + g * 64 + d); } }
#pragma unroll
        for (int q = 0; q < 4; ++q) { if (blk + q * F.G >= 8192) continue;
            v4u o = {0u, 0u, 0u, 0u};
            if (ok[q]) { const int l = c8v[q] >> 3, d = (c8v[q] & 7) * 8; const float* pp = pe + (size_t)whichv[q] * 2048 + l * 64 + d;
                const f32x4 p0 = *(const f32x4*)pp, p1 = *(const f32x4*)(pp + 4);
                o.x = pk2(bf2f((unsigned short)(hr[q].x & 0xffff)) + p0[0], bf2f((unsigned short)(hr[q].x >> 16)) + p0[1]); o.y = pk2(bf2f((unsigned short)(hr[q].y & 0xffff)) + p0[2], bf2f((unsigned short)(hr[q].y >> 16)) + p0[3]);
                o.z = pk2(bf2f((unsigned short)(hr[q].z & 0xffff)) + p1[0], bf2f((unsigned short)(hr[q].z >> 16)) + p1[1]); o.w = pk2(bf2f((unsigned short)(hr[q].w & 0xffff)) + p1[2], bf2f((unsigned short)(hr[q].w >> 16)) + p1[3]); }
            *(v4u*)(CA + ((size_t)whichv[q] * 8192 + rowv[q]) * 2048 + c8v[q] * 8) = o; }
    }
}

constexpr size_t MX_RLO = 2320 * MiB;
constexpr size_t MX_RLORA = 2336 * MiB;
constexpr size_t WS_WLORA = 42 * MiB;
DI void phase_rwkv_lo(const Args& a, Frame& F) {
    enter(F);
    const bf16* HB = (const bf16*)(F.ws + WS_HB); bf16* LO = (bf16*)(F.ws + MX_RLO); const float* mu = a.in[I_RW_MU];
    const int c8 = (F.tid & 31) * 8, seg = c8 < 64 ? 0 : c8 < 128 ? 1 : 2, col = seg == 0 ? RWL + c8 : seg == 1 ? RAL + (c8 - 64) : RGL + (c8 - 128);
    const f32x4 m0 = *(const f32x4*)(mu + col), m1 = *(const f32x4*)(mu + col + 4);
    const float mv[8] = {m0[0], m0[1], m0[2], m0[3], m1[0], m1[1], m1[2], m1[3]};
    for (int blk = F.bid; blk < T / 64; blk += F.G) {
        v4u cur[4], prv[4];
#pragma unroll
        for (int q = 0; q < 4; ++q) { const size_t t = (size_t)blk * 64 + q * 16 + (F.tid >> 5); const bf16* hp = HB + t * HC + col;
            cur[q] = *(const v4u*)hp; prv[q] = *(const v4u*)((t % SEQ) ? hp - HC : hp); }
#pragma unroll
        for (int q = 0; q < 4; ++q) { const size_t t = (size_t)blk * 64 + q * 16 + (F.tid >> 5); const bool first = (t % SEQ) == 0;
            v4u o;
#pragma unroll
            for (int d = 0; d < 4; ++d) { const unsigned cr = cur[q][d], pr = first ? 0u : prv[q][d];
                const float ha = __builtin_bit_cast(float, cr << 16), hb = __builtin_bit_cast(float, cr & 0xffff0000u), pa = __builtin_bit_cast(float, pr << 16), pb = __builtin_bit_cast(float, pr & 0xffff0000u);
                const float xa = ha + (pa - ha) * mv[2 * d], xb = hb + (pb - hb) * mv[2 * d + 1];
                o[d] = pk2(seg == 0 ? ftanh(xa) : seg == 1 ? xa : fsigmoid(xa), seg == 0 ? ftanh(xb) : seg == 1 ? xb : fsigmoid(xb)); }
            *(v4u*)(LO + t * 256 + c8) = o; }
    }
}
DI void phase_rwkv_out(const Args& a, Frame& F) {
    enter(F);
    const bf16* HB = (const bf16*)(F.ws + WS_HB); const bf16* LR = (const bf16*)(F.ws + MX_RLORA); const float* RO = (const float*)(F.ws + MX_RO); const float* BON = (const float*)(F.ws + MX_RBON);
    bf16* CAT = (bf16*)(F.ws + WS_CAT); const float* lnw = a.in[I_RW_LNW]; const float* lnb = a.in[I_RW_LNB]; const float* mu = a.in[I_RW_MU];
    typedef unsigned short u16x4 __attribute__((ext_vector_type(4))); typedef unsigned u32x2_ __attribute__((ext_vector_type(2)));
    const int gw = F.bid * 8 + F.wave, hq = F.lane >> 4, k0 = (F.lane & 15) * 4;
    for (int i = gw; i < T / 2; i += F.G * 8) {
        f32x4 x[2][3]; u16x4 hv[2][3], pv[2][3], gg[2][3]; float bn[2][3];
#pragma unroll
        for (int e = 0; e < 2; ++e) { const size_t t = (size_t)i * 2 + e; const bool first = (t % SEQ) == 0;
#pragma unroll
            for (int g = 0; g < 3; ++g) { const int head = hq + 4 * g, c = head * 64 + k0; const bf16* hp = HB + t * HC + RV + c;
                x[e][g] = *(const f32x4*)(RO + t * TOKW + c); hv[e][g] = *(const u16x4*)hp; pv[e][g] = *(const u16x4*)(first ? hp : hp - HC);
                gg[e][g] = *(const u16x4*)(LR + t * 2304 + 1536 + c); bn[e][g] = BON[t * 12 + head]; } }
#pragma unroll
        for (int e = 0; e < 2; ++e) { const size_t t = (size_t)i * 2 + e; const bool first = (t % SEQ) == 0;
#pragma unroll
            for (int g = 0; g < 3; ++g) { const int c = (hq + 4 * g) * 64 + k0; const f32x4 xv = x[e][g];
                float sm = xv[0] + xv[1] + xv[2] + xv[3];
                sm = row_sum16(sm);
                const float mean = sm * (1.0f / 64.0f); const f32x4 dx = xv - mean;
                float vs = dx[0] * dx[0] + dx[1] * dx[1] + dx[2] * dx[2] + dx[3] * dx[3];
                vs = row_sum16(vs);
                const float rs = __builtin_amdgcn_rsqf(vs * opq(1.0f / 64.0f) + opq(64e-5f));
                const f32x4 lw4 = *(const f32x4*)(lnw + c), lb4 = *(const f32x4*)(lnb + c), mu4 = *(const f32x4*)(mu + RV + c);
                float y[4];
#pragma unroll
                for (int d = 0; d < 4; ++d) { const float h = bf2f(hv[e][g][d]), p = first ? 0.f : bf2f(pv[e][g][d]); const float v = h + (p - h) * mu4[d];
                    y[d] = (dx[d] * rs * lw4[d] + lb4[d] + bn[e][g] * v) * bf2f(gg[e][g][d]); }
                *(u32x2_*)(CAT + t * D + c) = (u32x2_){pk2(y[0], y[1]), pk2(y[2], y[3])}; } }
    }
}

constexpr size_t MX_GQD = WS_MIX + 144 * MiB;
constexpr size_t MX_GKD = WS_MIX + 168 * MiB;
constexpr size_t MX_GKD2 = WS_MIX + 192 * MiB;
constexpr size_t MX_GEBL = WS_MIX + 216 * MiB;

DI void phase_gla_prep(const Args& a, Frame& F) {
    enter(F);
    const bf16* HB = (const bf16*)(F.ws + WS_HB);
    bf16* QD = (bf16*)(F.ws + MX_GQD); bf16* KD = (bf16*)(F.ws + MX_GKD); bf16* KD2 = (bf16*)(F.ws + MX_GKD2); float* EBL = (float*)(F.ws + MX_GEBL);
    const float* wa2 = a.in[I_GLA_WA2]; const float* ba = a.in[I_GLA_BA];
    float* AL = (float*)F.lds; float* BL = (float*)(F.lds + 4096); float* BC = (float*)(F.lds + 8192);
    const int tid = F.tid, cB = tid < 384 ? tid : 0;
    float w[16];
#pragma unroll
    for (int k = 0; k < 16; ++k) w[k] = wa2[k * 384 + cB];
    const float bac = ba[cB];
    for (int bn = F.bid; bn < BATCH * 64; bn += F.G) {
        const size_t t0 = (size_t)bn * 64;
        lds_barrier();
        v4u qv[6], kv[6];
#pragma unroll
        for (int q = 0; q < 6; ++q) { const int item = tid + 512 * q, s = item / 48, c8 = item % 48; const bf16* hp = HB + (t0 + s) * HC + c8 * 8;
            qv[q] = *(const v4u*)(hp + GQ); kv[q] = *(const v4u*)(hp + GK); }
        if (tid < 128) { const int tok = tid >> 1, hf = tid & 1; const v4u x = *(const v4u*)(HB + (t0 + tok) * HC + GALR + hf * 8); float* d = AL + tok * 16 + hf * 8;
            *(f32x4*)d = (f32x4){__builtin_bit_cast(float, x.x << 16), __builtin_bit_cast(float, x.x & 0xffff0000u), __builtin_bit_cast(float, x.y << 16), __builtin_bit_cast(float, x.y & 0xffff0000u)};
            *(f32x4*)(d + 4) = (f32x4){__builtin_bit_cast(float, x.z << 16), __builtin_bit_cast(float, x.z & 0xffff0000u), __builtin_bit_cast(float, x.w << 16), __builtin_bit_cast(float, x.w & 0xffff0000u)}; }
        lds_barrier();
        if (tid < 384) { float bc = 0.f;
#pragma unroll 4
            for (int s = 0; s < 64; ++s) { const f32x4* al = (const f32x4*)(AL + s * 16); float x = bac;
#pragma unroll
                for (int k4 = 0; k4 < 4; ++k4) { const f32x4 v = al[k4]; x += v[0] * w[4 * k4] + v[1] * w[4 * k4 + 1] + v[2] * w[4 * k4 + 2] + v[3] * w[4 * k4 + 3]; }
                bc += -fsoftplus(-x) * (1.0f / 16.0f); BC[s * 384 + tid] = bc; }
            BL[tid] = bc; EBL[(size_t)bn * 384 + tid] = fexp(bc); }
        lds_barrier();
#pragma unroll
        for (int q = 0; q < 6; ++q) { const int item = tid + 512 * q, s = item / 48, c = (item % 48) * 8; const size_t o = (t0 + s) * 384 + c;
            const f32x4 b0 = *(const f32x4*)(BC + s * 384 + c), b1 = *(const f32x4*)(BC + s * 384 + c + 4), l0 = *(const f32x4*)(BL + c), l1 = *(const f32x4*)(BL + c + 4);
            const float bcv[8] = {b0[0], b0[1], b0[2], b0[3], b1[0], b1[1], b1[2], b1[3]}, blv[8] = {l0[0], l0[1], l0[2], l0[3], l1[0], l1[1], l1[2], l1[3]};
            v4u oq, ok, o2;
#pragma unroll
            for (int d = 0; d < 4; ++d) { const unsigned qr = qv[q][d], kr = kv[q][d];
                const float bca = bcv[2 * d], bcb = bcv[2 * d + 1], bla = blv[2 * d], blb = blv[2 * d + 1];
                const float qa = __builtin_bit_cast(float, qr << 16) * 0.10206207261596575f, qb = __builtin_bit_cast(float, qr & 0xffff0000u) * 0.10206207261596575f;
                const float ka = __builtin_bit_cast(float, kr << 16), kb = __builtin_bit_cast(float, kr & 0xffff0000u);
                oq[d] = pk2(qa * fexp(bca), qb * fexp(bcb)); ok[d] = pk2(ka * fexp(-bca), kb * fexp(-bcb)); o2[d] = pk2(ka * fexp(bla - bca), kb * fexp(blb - bcb)); }
            *(v4u*)(QD + o) = oq; *(v4u*)(KD + o) = ok; *(v4u*)(KD2 + o) = o2; }
    }
}
constexpr int GVP = 400;
DI void phase_gla_intra(Frame& F, int b0) {
    enter(F);
    const bf16* HB = (const bf16*)(F.ws + WS_HB); const bf16* QD = (const bf16*)(F.ws + MX_GQD); const bf16* KD = (const bf16*)(F.ws + MX_GKD); float* GO = (float*)(F.ws + MX_GO);
    unsigned char* Vl = F.lds;
    const int lane = F.lane, r32 = lane & 31, hi = lane >> 5, w = F.wave;
    if (F.bid < b0) return;
    for (int u = F.bid - b0; u < BATCH * 64 * 4; u += F.G - b0) {
        const int h = u & 3, bn = u >> 2; const size_t t0 = (size_t)bn * 64;
        lds_barrier();
        for (int i = F.tid; i < 64 * 24; i += 512) { const int row = i / 24, ch = i % 24; *(v4u*)(Vl + row * GVP + ch * 16) = *(const v4u*)(HB + (t0 + row) * HC + GV + h * 192 + ch * 8); }
        lds_barrier();
        if (w < 6) {
            bf16x8 kf[2][6];
#pragma unroll
            for (int st = 0; st < 2; ++st)
#pragma unroll
                for (int kc = 0; kc < 6; ++kc) kf[st][kc] = *(const bf16x8*)(KD + (t0 + 32 * st + r32) * 384 + h * 96 + 16 * kc + 8 * hi);
#pragma unroll
            for (int ct = 0; ct < 2; ++ct) {
                bf16x8 qf[6];
#pragma unroll
                for (int kc = 0; kc < 6; ++kc) qf[kc] = *(const bf16x8*)(QD + (t0 + 32 * ct + r32) * 384 + h * 96 + 16 * kc + 8 * hi);
                f32x16 o;
#pragma unroll
                for (int r = 0; r < 16; ++r) o[r] = 0.f;
#pragma unroll
                for (int st = 0; st <= ct; ++st) {
                    f32x16 at;
#pragma unroll
                    for (int r = 0; r < 16; ++r) at[r] = 0.f;
#pragma unroll
                    for (int kc = 0; kc < 6; ++kc) at = MFMA32(kf[st][kc], qf[kc], at);
                    if (st == ct) {
#pragma unroll
                        for (int r = 0; r < 16; ++r) at[r] = (crow(r, hi) <= r32) ? at[r] : 0.f;
                    }
#pragma unroll
                    for (int s2 = 0; s2 < 2; ++s2) o = MFMA32(frag_col44(Vl, GVP, 32 * st + 16 * s2 + 4 * hi, 32 * w, lane), pack_acc(at, s2), o);
                }
                float* op = GO + (t0 + 32 * ct + r32) * TOKW + h * 192 + 32 * w;
#pragma unroll
                for (int rq = 0; rq < 4; ++rq) *(f32x4*)(op + 8 * rq + 4 * hi) = (f32x4){o[4 * rq], o[4 * rq + 1], o[4 * rq + 2], o[4 * rq + 3]};
            }
        }
    }
}
constexpr int GQP = 208;
constexpr int GEOFF = 2 * 64 * GQP + 64 * GVP;
constexpr int GBUF = GEOFF + 512;
constexpr size_t MX_GOI = WS_MIX + 224 * MiB;
DI void phase_gla_seq(Frame& F) {
    enter(F);
    const unsigned char* HBc = F.ws + WS_HB; const unsigned char* QDc = F.ws + MX_GQD; const unsigned char* KD2c = F.ws + MX_GKD2; const float* EBL = (const float*)(F.ws + MX_GEBL);
    float* GOI = (float*)(F.ws + MX_GOI);
    const int lane = F.lane, r32 = lane & 31, hi = lane >> 5, w = F.wave;
    unsigned gA[3], lA[3], gB[3], lB[3]; bool isq[3];
#pragma unroll
    for (int q = 0; q < 3; ++q) { const int i = F.tid + 512 * q; isq[q] = i < 768; const int i2 = isq[q] ? i : i - 768, row = i2 / 12, ch = i2 % 12;
        gA[q] = (unsigned)(row * 384 + ch * 8) * 2u; lA[q] = (unsigned)((isq[q] ? 0 : 64 * GQP) + row * GQP + ch * 16);
        const int rowv = i / 24, chv = i % 24; gB[q] = (unsigned)(rowv * HC + chv * 8) * 2u; lB[q] = (unsigned)(128 * GQP + rowv * GVP + chv * 16); }
    for (int u = F.bid; u < BATCH * 4; u += F.G) {
        const int b = u >> 2, h = u & 3;
        f32x16 S[3];
#pragma unroll
        for (int kt = 0; kt < 3; ++kt)
#pragma unroll
            for (int r = 0; r < 16; ++r) S[kt][r] = 0.f;
        v4u sr[3], sre = {0u, 0u, 0u, 0u};
#define GLA_LOAD_A(n) do { const size_t o_ = ((size_t)(b * 64 + (n)) * 64 * 384 + h * 96) * 2; _Pragma("unroll") for (int q_ = 0; q_ < 3; ++q_) sr[q_] = *(const v4u*)((isq[q_] ? QDc : KD2c) + o_ + gA[q_]); \
            if (F.tid < 24) sre = *(const v4u*)(EBL + (size_t)(b * 64 + (n)) * 384 + h * 96 + F.tid * 4); } while (0)
#define GLA_LOAD_B(n) do { const size_t o_ = ((size_t)(b * 64 + (n)) * 64 * HC + GV + h * 192) * 2; _Pragma("unroll") for (int q_ = 0; q_ < 3; ++q_) sr[q_] = *(const v4u*)(HBc + o_ + gB[q_]); } while (0)
#define GLA_STORE_A(buf) do { _Pragma("unroll") for (int q_ = 0; q_ < 3; ++q_) *(v4u*)(F.lds + (buf) * GBUF + lA[q_]) = sr[q_]; if (F.tid < 24) *(v4u*)(F.lds + (buf) * GBUF + GEOFF + F.tid * 16) = sre; } while (0)
#define GLA_STORE_B(buf) do { _Pragma("unroll") for (int q_ = 0; q_ < 3; ++q_) *(v4u*)(F.lds + (buf) * GBUF + lB[q_]) = sr[q_]; } while (0)
        lds_barrier();
        GLA_LOAD_A(0); GLA_STORE_A(0); GLA_LOAD_B(0); GLA_STORE_B(0);
        lds_barrier();
#pragma unroll 1
        for (int n = 0; n < 64; ++n) {
            const int buf = n & 1; const bool more = n + 1 < 64;
            const unsigned char* Ql = F.lds + buf * GBUF; const unsigned char* K2l = Ql + 64 * GQP; const unsigned char* Vl = Ql + 128 * GQP;
            if (more) GLA_LOAD_A(n + 1);
            if (w < 6) {
                bf16x8 Sp[3][2];
#pragma unroll
                for (int kt = 0; kt < 3; ++kt) { Sp[kt][0] = pack_acc(S[kt], 0); Sp[kt][1] = pack_acc(S[kt], 1); }
#pragma unroll
                for (int ct = 0; ct < 2; ++ct) {
                    f32x16 o;
#pragma unroll
                    for (int r = 0; r < 16; ++r) o[r] = 0.f;
#pragma unroll
                    for (int kt = 0; kt < 3; ++kt)
#pragma unroll
                        for (int s2 = 0; s2 < 2; ++s2) {
                            const unsigned char* qp = Ql + (32 * ct + r32) * GQP + (32 * kt + 16 * s2 + 4 * hi) * 2;
                            const v2u lo = *(const v2u*)qp, hi8 = *(const v2u*)(qp + 16);
                            const v4u qa = {lo.x, lo.y, hi8.x, hi8.y};
                            o = MFMA32(__builtin_bit_cast(bf16x8, qa), Sp[kt][s2], o);
                        }
                    float* op = GOI + ((((size_t)(b * 64 + n) * 4 + h) * 6 + w) * 2 + ct) * 1024 + lane;
#pragma unroll
                    for (int r = 0; r < 16; ++r) op[r * 64] = o[r];
                    __builtin_amdgcn_sched_barrier(0);
                }
            }
            if (more) { GLA_STORE_A(buf ^ 1); GLA_LOAD_B(n + 1); }
            if (w < 6) {
#pragma unroll
                for (int kt = 0; kt < 3; ++kt) {
                    const float* eb = (const float*)(Ql + GEOFF) + 32 * kt + 4 * hi;
#pragma unroll
                    for (int rq = 0; rq < 4; ++rq) { const f32x4 e4 = *(const f32x4*)(eb + 8 * rq);
                        S[kt][4 * rq] *= e4[0]; S[kt][4 * rq + 1] *= e4[1]; S[kt][4 * rq + 2] *= e4[2]; S[kt][4 * rq + 3] *= e4[3]; }
#pragma unroll
                    for (int st = 0; st < 4; ++st)
                        S[kt] = MFMA32(frag_col8(K2l, GQP, 16 * st + 8 * hi, 32 * kt, lane), frag_col8(Vl, GVP, 16 * st + 8 * hi, 32 * w, lane), S[kt]);
                    __builtin_amdgcn_sched_barrier(0);
                }
            }
            if (more) GLA_STORE_B(buf ^ 1);
            lds_barrier();
        }
#undef GLA_LOAD_A
#undef GLA_LOAD_B
#undef GLA_STORE_A
#undef GLA_STORE_B
    }
}
DI void phase_gla_out2(const Args& a, Frame& F) {
    enter(F);
    const bf16* HB = (const bf16*)(F.ws + WS_HB); const float* GO = (const float*)(F.ws + MX_GO); const float* GOI = (const float*)(F.ws + MX_GOI); bf16* CAT = (bf16*)(F.ws + WS_CAT);
    const float* nw = a.in[I_GLA_NW]; const float* bog = a.in[I_GLA_BOG];
    typedef unsigned short u16x4 __attribute__((ext_vector_type(4))); typedef unsigned u32x2_ __attribute__((ext_vector_type(2)));
    const int gw = F.bid * 8 + F.wave, h = F.lane >> 4, v0 = (F.lane & 15) * 4;
    f32x4 nwv[3], bgv[3];
#pragma unroll
    for (int e = 0; e < 3; ++e) { nwv[e] = *(const f32x4*)(nw + e * 64 + v0); bgv[e] = *(const f32x4*)(bog + h * 192 + e * 64 + v0); }
    for (int i = gw; i < T / 2; i += F.G * 8) {
        f32x4 o[2][3], oi[2][3]; u16x4 og[2][3];
#pragma unroll
        for (int e2 = 0; e2 < 2; ++e2) { const size_t t = (size_t)i * 2 + e2; const int bn = (int)(t >> 6), c = (int)(t & 63), ct = c >> 5, cc = c & 31, hi2 = (cc >> 2) & 1, reg = (cc & 3) + 4 * (cc >> 3);
#pragma unroll
            for (int e = 0; e < 3; ++e) { const int v = e * 64 + v0, w2 = v >> 5;
                o[e2][e] = *(const f32x4*)(GO + t * TOKW + h * 192 + v);
                oi[e2][e] = *(const f32x4*)(GOI + ((((size_t)bn * 4 + h) * 6 + w2) * 2 + ct) * 1024 + reg * 64 + hi2 * 32 + (v & 31));
                og[e2][e] = *(const u16x4*)(HB + t * HC + GOG + h * 192 + v); } }
#pragma unroll
        for (int e2 = 0; e2 < 2; ++e2) { const size_t t = (size_t)i * 2 + e2;
            float ss = 0.f;
#pragma unroll
            for (int e = 0; e < 3; ++e) { o[e2][e] += oi[e2][e]; const f32x4 x = o[e2][e]; ss += x[0] * x[0] + x[1] * x[1] + x[2] * x[2] + x[3] * x[3]; }
            ss = row_sum16(ss);
            const float rs = 1.0f / sqrtf(ss * opq(1.0f / 192.0f) + opq(LN_EPS));
            bf16* cp = CAT + t * D + h * 192;
#pragma unroll
            for (int e = 0; e < 3; ++e) { float y[4];
#pragma unroll
                for (int d = 0; d < 4; ++d) { const float z = bf2f(og[e2][e][d]) + bgv[e][d]; y[d] = o[e2][e][d] * rs * nwv[e][d] * (z * fsigmoid(z)); }
                *(u32x2_*)(cp + e * 64 + v0) = (u32x2_){pk2(y[0], y[1]), pk2(y[2], y[3])}; } }
    }
}

constexpr size_t MX_RA3 = 1776 * MiB;
constexpr size_t MX_RA1 = 1872 * MiB;
constexpr size_t MX_ROL = 1920 * MiB;
constexpr size_t MX_RSL = 1968 * MiB;
constexpr int RFP = 68;
constexpr int RBP = 144;
constexpr int RMP = 80;
constexpr int RL_LW = 0, RL_CUM = 8704, RL_AF = 17408, RL_RF = 26112, RL_KPF = 34816, RL_BBF = 43520;
constexpr int RL_AT = 52224, RL_RT = 56832, RL_BT = 61440, RL_KT = 66048, RL_BP = 70656, RL_VB = 75264;
constexpr int RL_MABT = 79872;
constexpr int RL_MAK = 83968;
constexpr int RL_MBR = 88192;
constexpr int RL_MKR = 90752;
constexpr int RL_W1 = 94848;
constexpr int RL_W2 = 99968;
constexpr int RL_PC = 102528;
constexpr int RL_MP = 102784;
constexpr int RL_XL = 79872;

DI void phase_rwkv_chunk(const Args& a, Frame& F) {
    enter(F);
    const bf16* HB = (const bf16*)(F.ws + WS_HB); const bf16* LR = (const bf16*)(F.ws + MX_RLORA); float* BON = (float*)(F.ws + MX_RBON);
    const float* mu = a.in[I_RW_MU], *w0 = a.in[I_RW_W0], *a0 = a.in[I_RW_A0], *k_k = a.in[I_RW_KK], *k_a = a.in[I_RW_KA], *r_k = a.in[I_RW_RK];
    unsigned char* L = F.lds;
    float* LW = (float*)(L + RL_LW), *CUM = (float*)(L + RL_CUM), *AF = (float*)(L + RL_AF), *RF = (float*)(L + RL_RF), *KPF = (float*)(L + RL_KPF), *BBF = (float*)(L + RL_BBF);
    float* MKR = (float*)(L + RL_MKR), *PC = (float*)(L + RL_PC);
    const int w = F.wave;
    typedef unsigned short u16x4 __attribute__((ext_vector_type(4)));
    u16x4 hr4, hk4, hv4, pr4, pk4, pv4, aw4, aa4; f32x4 mur, muk, muv, w0c, a0c, kkc, kac, rkc;
#define RW_FETCH(uu) do { const int n_ = (uu) & 127, bh_ = (uu) >> 7, b_ = bh_ / 12, head_ = bh_ % 12; int ln_ = F.lane; asm volatile("" : "+v"(ln_)); \
        const int c0_ = head_ * 64 + (ln_ & 15) * 4; const size_t t_ = (size_t)b_ * SEQ + 32 * n_ + w * 4 + (ln_ >> 4); const bool first_ = (t_ % SEQ) == 0; \
        const bf16* hp_ = HB + t_ * HC + c0_; const bf16* pp_ = first_ ? hp_ : hp_ - HC; const bf16* lr_ = LR + t_ * 2304 + c0_; \
        hr4 = *(const u16x4*)(hp_ + RR); hk4 = *(const u16x4*)(hp_ + RK); hv4 = *(const u16x4*)(hp_ + RV); pr4 = *(const u16x4*)(pp_ + RR); pk4 = *(const u16x4*)(pp_ + RK); pv4 = *(const u16x4*)(pp_ + RV); \
        aw4 = *(const u16x4*)lr_; aa4 = *(const u16x4*)(lr_ + 768); \
        mur = *(const f32x4*)(mu + RR + c0_); muk = *(const f32x4*)(mu + RK + c0_); muv = *(const f32x4*)(mu + RV + c0_); \
        w0c = *(const f32x4*)(w0 + c0_); a0c = *(const f32x4*)(a0 + c0_); kkc = *(const f32x4*)(k_k + c0_); kac = *(const f32x4*)(k_a + c0_); rkc = *(const f32x4*)(r_k + c0_); } while (0)
    if (F.bid < BATCH * 12 * 128) RW_FETCH(F.bid);
    for (int u = F.bid; u < BATCH * 12 * 128; u += F.G) {
        int lane_ = F.lane; asm volatile("" : "+v"(lane_));
        const int lane = lane_, r32 = lane & 31, hi = lane >> 5;
        const int n = u & 127, bh = u >> 7, b = bh / 12, head = bh % 12; const size_t t0 = (size_t)b * SEQ + 32 * n;
        const int tidl = w * 64 + lane;
        lds_barrier();
        {
            const int tt = w * 4 + (lane >> 4), k0 = (lane & 15) * 4, o = tt * RFP + k0; const size_t t = t0 + tt;
            const bool first = (t % SEQ) == 0;
            f32x4 r, kx, wl, av, kk0; float s2 = 0.f; unsigned vb[4];
#pragma unroll
            for (int q = 0; q < 4; ++q) {
                const float hr = bf2f(hr4[q]), hk = bf2f(hk4[q]), hv = bf2f(hv4[q]);
                r[q] = hr + ((first ? 0.f : bf2f(pr4[q])) - hr) * mur[q];
                kx[q] = hk + ((first ? 0.f : bf2f(pk4[q])) - hk) * muk[q];
                vb[q] = f2bf(hv + ((first ? 0.f : bf2f(pv4[q])) - hv) * muv[q]);
                wl[q] = -fexp(-fsoftplus(-(w0c[q] + bf2f(aw4[q]))) - 0.5f);
                av[q] = fsigmoid(a0c[q] + bf2f(aa4[q]));
                kk0[q] = kx[q] * kkc[q]; s2 += kk0[q] * kk0[q]; }
            s2 = row_sum16(s2);
            const float rn = __builtin_amdgcn_rsqf(fmaxf(s2, 1e-24f));
            f32x4 kp, nk, bb; float bon = 0.f;
#pragma unroll
            for (int q = 0; q < 4; ++q) { kp[q] = kx[q] * (1.0f + (av[q] - 1.0f) * kac[q]); bon += r[q] * kp[q] * rkc[q]; const float kk = kk0[q] * rn; nk[q] = -kk; bb[q] = kk * av[q]; }
            bon = row_sum16(bon);
            if ((lane & 15) == 0) BON[t * 12 + head] = bon;
            *(f32x4*)(RF + o) = r; *(f32x4*)(LW + o) = wl; *(f32x4*)(KPF + o) = kp; *(f32x4*)(AF + o) = nk; *(f32x4*)(BBF + o) = bb;
            typedef unsigned u32x2_ __attribute__((ext_vector_type(2)));
            *(u32x2_*)(L + RL_VB + tt * RBP + k0 * 2) = (u32x2_){vb[0] | (vb[1] << 16), vb[2] | (vb[3] << 16)};
        }
        if (u + F.G < BATCH * 12 * 128) RW_FETCH(u + F.G);
        lds_barrier();
#pragma unroll
        for (int q = 0; q < 4; ++q) { const int k = (tidl >> 5) * 4 + q, tt = tidl & 31; float c = LW[tt * RFP + k];
            c += __builtin_bit_cast(float, __builtin_amdgcn_update_dpp(0, __builtin_bit_cast(int, c), 0x111, 0xf, 0xf, true));
            c += __builtin_bit_cast(float, __builtin_amdgcn_update_dpp(0, __builtin_bit_cast(int, c), 0x112, 0xf, 0xf, true));
            c += __builtin_bit_cast(float, __builtin_amdgcn_update_dpp(0, __builtin_bit_cast(int, c), 0x114, 0xf, 0xf, true));
            c += __builtin_bit_cast(float, __builtin_amdgcn_update_dpp(0, __builtin_bit_cast(int, c), 0x118, 0xf, 0xf, true));
            c += __builtin_bit_cast(float, __builtin_amdgcn_update_dpp(0, __builtin_bit_cast(int, c), 0x142, 0xa, 0xf, false));
            CUM[tt * RFP + k] = c; if (tt == 31) PC[k] = fexp(c); }
        lds_barrier();
#pragma unroll
        for (int q = 0; q < 4; ++q) { const int i = tidl + 512 * q, tt = i >> 6, k = i & 63, o = tt * RFP + k;
            const float cu = CUM[o], cC = CUM[31 * RFP + k], lwv = LW[o], av = AF[o], rv = RF[o], kv = KPF[o], bv = BBF[o];
            const float en = fexp(-cu), ep = fexp(cu), ec = fexp(cC - cu);
            const float at = av * fexp(cu - lwv), rt = rv * ep, kp = kv * ec;
            AF[o] = at; RF[o] = rt; KPF[o] = kp;
            const int ob = tt * RBP + k * 2;
            *(bf16*)(L + RL_AT + ob) = (bf16)f2bf(at); *(bf16*)(L + RL_RT + ob) = (bf16)f2bf(rt); *(bf16*)(L + RL_BT + ob) = (bf16)f2bf(bv * en);
            *(bf16*)(L + RL_KT + ob) = (bf16)f2bf(kv * en); *(bf16*)(L + RL_BP + ob) = (bf16)f2bf(bv * ec); }
        lds_barrier();
        f32x16 xt;
#pragma unroll
        for (int r = 0; r < 16; ++r) xt[r] = 0.f;
        if (w < 4) {
            const unsigned char* Am = L + ((w == 0 || w == 1) ? RL_BT : RL_KT); const unsigned char* Bm = L + ((w == 1 || w == 3) ? RL_RT : RL_AT);
            f32x16 m;
#pragma unroll
            for (int r = 0; r < 16; ++r) m[r] = 0.f;
#pragma unroll
            for (int kc = 0; kc < 4; ++kc) m = MFMA32(frag_row(Am, RBP, r32, 16 * kc + 8 * hi), frag_row(Bm, RBP, r32, 16 * kc + 8 * hi), m);
#pragma unroll
            for (int r = 0; r < 16; ++r) { const int s = crow(r, hi); const bool keep = (w == 1 || w == 3) ? (s <= r32) : (s < r32); m[r] = keep ? m[r] : 0.f; }
            if (w == 0) {
#pragma unroll
                for (int r = 0; r < 16; ++r) *(bf16*)(L + RL_MP + crow(r, hi) * RMP + r32 * 2) = (bf16)f2bf(m[r]);
            } else if (w == 1) {
#pragma unroll
                for (int r = 0; r < 16; ++r) *(bf16*)(L + RL_MBR + crow(r, hi) * RMP + r32 * 2) = (bf16)f2bf(m[r]);
            } else if (w == 2) {
                xt = m;
            } else {
#pragma unroll
                for (int r = 0; r < 16; ++r) MKR[r * 64 + lane] = m[r];
            }
        }
        if (w < 2) {
#pragma unroll
            for (int rq = 0; rq < 4; ++rq) { const f32x4 y4 = *(const f32x4*)(AF + r32 * RFP + 32 * w + 8 * rq + 4 * hi); xt[4 * rq] = y4[0]; xt[4 * rq + 1] = y4[1]; xt[4 * rq + 2] = y4[2]; xt[4 * rq + 3] = y4[3]; }
        }
        lds_barrier();
#define RW_APPLY(kp) do { unsigned char* xl_ = L + RL_XL + w * (32 * RMP); \
            _Pragma("unroll") for (int r = 0; r < 16; ++r) *(bf16*)(xl_ + crow(r, hi) * RMP + r32 * 2) = (bf16)f2bf(xt[r]); \
            asm volatile("s_waitcnt lgkmcnt(0)" ::: "memory"); \
            _Pragma("unroll") for (int tc = 0; tc < 2; ++tc) xt = MFMA32(frag_row(xl_, RMP, r32, 16 * tc + 8 * hi), frag_col8(L + RL_MP + (kp) * (32 * RMP), RMP, 16 * tc + 8 * hi, 0, lane), xt); } while (0)
        if (w < 3) { RW_APPLY(0); }
        else if (w == 3) {
#pragma unroll 1
            for (int kp = 1; kp < 5; ++kp) { const unsigned char* src = L + RL_MP + (kp - 1) * (32 * RMP); unsigned char* dst = L + RL_MP + kp * (32 * RMP);
                f32x16 m2;
#pragma unroll
                for (int r = 0; r < 16; ++r) m2[r] = 0.f;
#pragma unroll
                for (int tc = 0; tc < 2; ++tc) m2 = MFMA32(frag_row(src, RMP, r32, 16 * tc + 8 * hi), frag_col8(src, RMP, 16 * tc + 8 * hi, 0, lane), m2);
#pragma unroll
                for (int r = 0; r < 16; ++r) *(bf16*)(dst + crow(r, hi) * RMP + r32 * 2) = (bf16)f2bf(m2[r]);
                asm volatile("s_waitcnt lgkmcnt(0)" ::: "memory"); }
        }
        lds_barrier();
        if (w < 3) {
            RW_APPLY(1); RW_APPLY(2); RW_APPLY(3); RW_APPLY(4);
            unsigned char* dst = L + (w < 2 ? RL_W1 + (32 * w) * RMP : RL_W2);
#pragma unroll
            for (int r = 0; r < 16; ++r) *(bf16*)(dst + crow(r, hi) * RMP + r32 * 2) = (bf16)f2bf(xt[r]);
        }
#undef RW_APPLY
        lds_barrier();
#define RW_G4(kpt) do {\
                f32x16 g;\
_Pragma("unroll")\
                for (int r = 0; r < 16; ++r) g[r] = KPF[crow(r, hi) * RFP + 32 * kpt + r32];\
_Pragma("unroll")\
                for (int tc = 0; tc < 2; ++tc) g = MFMA32(frag_row(L + RL_W2, RMP, r32, 16 * tc + 8 * hi), frag_col8(L + RL_BP, RBP, 16 * tc + 8 * hi, 32 * kpt, lane), g);\
                const bf16x8 ga = pack_acc(g, 0), gb = pack_acc(g, 1);\
_Pragma("unroll")\
                for (int vt = 0; vt < 2; ++vt) { f32x16 z;\
_Pragma("unroll")\
                    for (int r = 0; r < 16; ++r) z[r] = 0.f;\
                    z = MFMA32(ga, frag_col44(L + RL_VB, RBP, 4 * hi, 32 * vt, lane), z); z = MFMA32(gb, frag_col44(L + RL_VB, RBP, 16 + 4 * hi, 32 * vt, lane), z);\
                    unsigned* dst = (unsigned*)(F.ws + MX_RSL) + (((size_t)u * 2 + kpt) * 2 + vt) * 512 + lane;\
_Pragma("unroll")\
                    for (int p = 0; p < 8; ++p) dst[p * 64] = cvtpk(z[2 * p], z[2 * p + 1]); }\
        } while (0)
        if (w < 4) {
            const int kt = w >> 1, kpt = w & 1;
            f32x16 g;
#pragma unroll
            for (int r = 0; r < 16; ++r) g[r] = 0.f;
#pragma unroll
            for (int tc = 0; tc < 2; ++tc) g = MFMA32(frag_row(L + RL_W1, RMP, 32 * kt + r32, 16 * tc + 8 * hi), frag_col8(L + RL_BP, RBP, 16 * tc + 8 * hi, 32 * kpt, lane), g);
            if (kt == kpt) { const float pcv = PC[32 * kt + r32];
#pragma unroll
                for (int r = 0; r < 16; ++r) g[r] += (crow(r, hi) == r32) ? pcv : 0.f; }
            unsigned char* dst = F.ws + MX_RA3 + (size_t)u * 8192 + (size_t)((kpt * 2 + kt) * 2) * 1024 + lane * 16;
            *(bf16x8*)dst = pack_acc(g, 0); *(bf16x8*)(dst + 1024) = pack_acc(g, 1);
            if (w == 3) RW_G4(1);
        } else if (w < 6) {
            const int kt = w - 4;
            f32x16 g;
#pragma unroll
            for (int r = 0; r < 16; ++r) g[r] = 0.f;
#pragma unroll
            for (int sc = 0; sc < 2; ++sc) g = MFMA32(frag_row(L + RL_W1, RMP, 32 * kt + r32, 16 * sc + 8 * hi), frag_col8(L + RL_MBR, RMP, 16 * sc + 8 * hi, 0, lane), g);
#pragma unroll
            for (int rq = 0; rq < 4; ++rq) { const f32x4 rv = *(const f32x4*)(RF + r32 * RFP + 32 * kt + 8 * rq + 4 * hi); g[4 * rq] += rv[0]; g[4 * rq + 1] += rv[1]; g[4 * rq + 2] += rv[2]; g[4 * rq + 3] += rv[3]; }
            unsigned char* dst = F.ws + MX_RA1 + (size_t)u * 4096 + (size_t)(kt * 2) * 1024 + lane * 16;
            *(bf16x8*)dst = pack_acc(g, 0); *(bf16x8*)(dst + 1024) = pack_acc(g, 1);
        } else if (w == 6) {
            f32x16 g;
#pragma unroll
            for (int r = 0; r < 16; ++r) g[r] = MKR[r * 64 + lane];
#pragma unroll
            for (int sc = 0; sc < 2; ++sc) g = MFMA32(frag_row(L + RL_W2, RMP, r32, 16 * sc + 8 * hi), frag_col8(L + RL_MBR, RMP, 16 * sc + 8 * hi, 0, lane), g);
            const bf16x8 ga = pack_acc(g, 0), gb = pack_acc(g, 1);
#pragma unroll
            for (int vt = 0; vt < 2; ++vt) { f32x16 z;
#pragma unroll
                for (int r = 0; r < 16; ++r) z[r] = 0.f;
                z = MFMA32(ga, frag_col44(L + RL_VB, RBP, 4 * hi, 32 * vt, lane), z); z = MFMA32(gb, frag_col44(L + RL_VB, RBP, 16 + 4 * hi, 32 * vt, lane), z);
                unsigned* dst = (unsigned*)(F.ws + MX_ROL) + ((size_t)u * 2 + vt) * 512 + lane;
#pragma unroll
                for (int p = 0; p < 8; ++p) dst[p * 64] = cvtpk(z[2 * p], z[2 * p + 1]); }
        } else {
            RW_G4(0);
        }
    }
#undef RW_G4
#undef RW_FETCH
}
DI void phase_rwkv_seq(Frame& F) {
    enter(F);
    float* RO = (float*)(F.ws + MX_RO);
    const int lane = F.lane, r32 = lane & 31, hi = lane >> 5, vt = F.wave;
    if (F.bid < BATCH * 12 && vt < 2) {
        const int b = F.bid / 12, head = F.bid % 12;
        f32x16 X[2];
#pragma unroll
        for (int kt = 0; kt < 2; ++kt)
#pragma unroll
            for (int r = 0; r < 16; ++r) X[kt][r] = 0.f;
        bf16x8 n3[8], n1[4]; unsigned nol[8], nsl[2][8];
#define RS_FETCH(nn) do { const size_t u_ = (size_t)F.bid * 128 + (nn); \
            const unsigned char* a3p = F.ws + MX_RA3 + u_ * 8192 + lane * 16; const unsigned char* a1p = F.ws + MX_RA1 + u_ * 4096 + lane * 16; \
            const unsigned* olp = (const unsigned*)(F.ws + MX_ROL) + (u_ * 2 + vt) * 512 + lane; const unsigned* slp = (const unsigned*)(F.ws + MX_RSL) + (u_ * 4 + vt) * 512 + lane; \
            _Pragma("unroll") for (int f = 0; f < 8; ++f) n3[f] = *(const bf16x8*)(a3p + f * 1024); \
            _Pragma("unroll") for (int f = 0; f < 4; ++f) n1[f] = *(const bf16x8*)(a1p + f * 1024); \
            _Pragma("unroll") for (int p = 0; p < 8; ++p) { nol[p] = olp[p * 64]; nsl[0][p] = slp[p * 64]; nsl[1][p] = slp[1024 + p * 64]; } } while (0)
        RS_FETCH(0);
#pragma unroll 1
        for (int n = 0; n < 128; ++n) {
            bf16x8 a3[8], a1[4]; unsigned ol[8], sl[2][8];
#pragma unroll
            for (int f = 0; f < 8; ++f) a3[f] = n3[f];
#pragma unroll
            for (int f = 0; f < 4; ++f) a1[f] = n1[f];
#pragma unroll
            for (int p = 0; p < 8; ++p) { ol[p] = nol[p]; sl[0][p] = nsl[0][p]; sl[1][p] = nsl[1][p]; }
            if (n + 1 < 128) RS_FETCH(n + 1);
            bf16x8 Xp[2][2];
#pragma unroll
            for (int kt = 0; kt < 2; ++kt) { Xp[kt][0] = pack_acc(X[kt], 0); Xp[kt][1] = pack_acc(X[kt], 1); }
            f32x16 O;
#pragma unroll
            for (int p = 0; p < 8; ++p) { O[2 * p] = __builtin_bit_cast(float, ol[p] << 16); O[2 * p + 1] = __builtin_bit_cast(float, ol[p] & 0xffff0000u); }
#pragma unroll
            for (int kt = 0; kt < 2; ++kt)
#pragma unroll
                for (int s = 0; s < 2; ++s) O = MFMA32(a1[kt * 2 + s], Xp[kt][s], O);
            float* op = RO + ((size_t)b * SEQ + 32 * n + 4 * hi) * TOKW + head * 64 + 32 * vt + r32;
#pragma unroll
            for (int r = 0; r < 16; ++r) op[(size_t)((r & 3) + 8 * (r >> 2)) * TOKW] = O[r];
#pragma unroll
            for (int kpt = 0; kpt < 2; ++kpt) { f32x16 Xn;
#pragma unroll
                for (int p = 0; p < 8; ++p) { Xn[2 * p] = __builtin_bit_cast(float, sl[kpt][p] << 16); Xn[2 * p + 1] = __builtin_bit_cast(float, sl[kpt][p] & 0xffff0000u); }
#pragma unroll
                for (int kt = 0; kt < 2; ++kt)
#pragma unroll
                    for (int s = 0; s < 2; ++s) Xn = MFMA32(a3[(kpt * 2 + kt) * 2 + s], Xp[kt][s], Xn);
                X[kpt] = Xn; }
        }
    }
#undef RS_FETCH
}

DI void phase_nsa_cmp2(Frame& F, int j, bool own) {
    enter(F);
    const bf16* CH = (const bf16*)(F.ws + MX_CMPH); const bf16* W2T = (const bf16*)(F.ws + WS_CW2T) + (size_t)j * 2 * 64 * 256;
    const int lane = F.lane, r32 = lane & 31, hi = lane >> 5;
    const int gw = F.bid * 8 + F.wave, NGW = F.G * 8;
    for (int u = own ? (F.bid < 64 ? F.bid * 8 + F.wave : 2 * 256) : gw; u < 2 * 256; u += own ? 2 * 256 : NGW) {
        const int which = u >> 8, rt = u & 255;
        const bf16* ap = CH + ((size_t)which * 8192 + rt * 32 + r32) * 256 + 8 * hi; const bf16* bp = W2T + ((size_t)which * 64 + r32) * 256 + 8 * hi;
        f32x16 o0, o1;
#pragma unroll
        for (int r = 0; r < 16; ++r) { o0[r] = 0.f; o1[r] = 0.f; }
#pragma unroll
        for (int ks = 0; ks < 16; ++ks) { const bf16x8 af = *(const bf16x8*)(ap + 16 * ks);
            o0 = MFMA32(af, *(const bf16x8*)(bp + 16 * ks), o0); o1 = MFMA32(af, *(const bf16x8*)(bp + 32 * 256 + 16 * ks), o1); }
        bf16* dst = (bf16*)(F.ws + (which ? MX_VCB : MX_KCB));
#pragma unroll
        for (int r = 0; r < 16; ++r) { const int row = rt * 32 + crow(r, hi);
            if (row < BATCH * NC * 4) { const int g = row & 3, bn = row >> 2, b = bn / NC, n = bn % NC; bf16* p = dst + ((size_t)(b * 4 + g) * 256 + n) * 64;
                p[r32] = (bf16)f2bf(o0[r]); p[32 + r32] = (bf16)f2bf(o1[r]); } }
    }
    for (int blk = F.bid; blk < 2 * BATCH * 4 * 64 / 512; blk += F.G) { const int i = blk * 512 + F.tid; const int which = i >> 11, bg = (i >> 6) & 31, dd = i & 63;
        ((bf16*)(F.ws + (which ? MX_VCB : MX_KCB)))[((size_t)bg * 256 + 255) * 64 + dd] = 0; }
}

DI void cmp_scores(f32x16& p0, f32x16& p1, const unsigned char* Kl, const bf16x8 (&qf)[4], int lane, int kt, int tqm, int tqm0, const float* btab) {
    const int r32 = lane & 31, hi = lane >> 5;
#pragma unroll
    for (int i = 0; i < 16; ++i) { p0[i] = 0.f; p1[i] = 0.f; }
    const unsigned char* kb = Kl + kt * KVTILE + r32 * KVP + hi * 16;
#pragma unroll
    for (int dc = 0; dc < 4; ++dc) {
        const bf16x8 k0 = *(const bf16x8*)(kb + dc * 32), k1 = *(const bf16x8*)(kb + 32 * KVP + dc * 32);
        p0 = MFMA32(k0, qf[dc], p0); p1 = MFMA32(k1, qf[dc], p1);
    }
    if (tqm0 - 16 * (64 * kt + 63) >= 128) { const float cf = btab[191];
#pragma unroll
        for (int r = 0; r < 16; ++r) { p0[r] = p0[r] * LOG2E + cf; p1[r] = p1[r] * LOG2E + cf; }
        return; }
    int db = tqm - 16 * (64 * kt + 4 * hi); asm volatile("" : "+v"(db));
#pragma unroll
    for (int r = 0; r < 16; ++r) {
        const int d0 = db - 16 * ((r & 3) + 8 * (r >> 2)), d1 = d0 - 512;
        const float b0 = btab[d0 < 0 ? 0 : (d0 > 191 ? 191 : d0)], b1 = btab[d1 < 0 ? 0 : (d1 > 191 ? 191 : d1)];
        p0[r] = d0 >= 0 ? p0[r] * LOG2E + b0 : -1e30f;
        p1[r] = d1 >= 0 ? p1[r] * LOG2E + b1 : -1e30f;
    }
}
DI void phase_nsa_cmpattn_mfma(const Args& a, Frame& F) {
    enter(F);
    const bf16* HB = (const bf16*)(F.ws + WS_HB); const bf16* KCB = (const bf16*)(F.ws + MX_KCB); const bf16* VCB = (const bf16*)(F.ws + MX_VCB);
    float* OC = (float*)(F.ws + MX_OC); unsigned long long* SELM = (unsigned long long*)(F.ws + MX_SELM);
    const float* rel = a.in[I_REL];
    unsigned char* Kl = F.lds; unsigned char* Vl = F.lds + 4 * KVTILE; float* btab = (float*)(F.lds + 8 * KVTILE);
    const int lane = F.lane, r32 = lane & 31, hi = lane >> 5;
    for (int u = F.bid; u < BATCH * 4 * 16; u += F.G) {
        const int b = u >> 6, g = (u >> 4) & 3, qt = ((u >> 8) & 1) ? 15 - (u & 15) : (u & 15);
        lds_barrier();
#pragma unroll
        for (int kt = 0; kt < 4; ++kt) { if (kt > (qt * 256 + 255 - 31) / 1024) continue;
            KVRegs R; const size_t off = ((size_t)(b * 4 + g) * 256 + kt * 64) * 64; kv_load(R, KCB + off, VCB + off, 64, F.tid); kv_store(R, Kl + kt * KVTILE, Vl + kt * KVTILE, F.tid); }
        { int tl = F.tid; asm volatile("" : "+v"(tl)); for (int i = tl; i < 576; i += 512) { const int r = i / 192, dd = i % 192; btab[i] = rel[t5_bucket(dd) * 12 + g * 3 + r] * LOG2E; } }
        lds_barrier();
        const int tq = qt * 256 + F.wave * 32 + r32, t = b * SEQ + tq, tqm = tq - 31;
        const int tqm0 = __builtin_amdgcn_readfirstlane(qt * 256 + F.wave * 32 - 31);
        const int ntile = (__builtin_amdgcn_readfirstlane(qt * 256 + F.wave * 32 + 31 - 31) / 16) / 64 + 1;
        float self[32];
#pragma unroll
        for (int i = 0; i < 32; ++i) self[i] = 0.f;
#pragma unroll 1
        for (int r = 0; r < 3; ++r) {
            const int hh = g * 3 + r;
            bf16x8 qf[4]; load_q(qf, HB + (size_t)t * HC + NQ + hh * 64, hi);
            const float* bt = btab + r * 192;
            float m = -1e30f, l = 0.f, carry = 0.f;
            f32x16 o0, o1; float imp[32];
#pragma unroll
            for (int i = 0; i < 16; ++i) { o0[i] = 0.f; o1[i] = 0.f; }
#pragma unroll
            for (int i = 0; i < 32; ++i) imp[i] = 0.f;
#pragma unroll 1
            for (int kt = 0; kt < ntile; ++kt) {
                f32x16 p0, p1; cmp_scores(p0, p1, Kl, qf, lane, kt, tqm, tqm0, bt);
                float mx = fmaxf(p0[0], p1[0]);
#pragma unroll
                for (int i = 1; i < 16; ++i) mx = fmaxf(mx, fmaxf(p0[i], p1[i]));
                mx = xmax_half(mx);
                const float mn = fmaxf(m, mx);
                if (__any(mn > m)) { const float alpha = __builtin_amdgcn_exp2f(m - mn); l *= alpha; carry *= alpha;
#pragma unroll
                    for (int i = 0; i < 16; ++i) { o0[i] *= alpha; o1[i] *= alpha; }
#pragma unroll
                    for (int i = 0; i < 32; ++i) imp[i] *= alpha;
                    m = mn; }
                float rs = 0.f;
#pragma unroll
                for (int i = 0; i < 16; ++i) { p0[i] = (p0[i] > -1e29f) ? __builtin_amdgcn_exp2f(p0[i] - m) : 0.f; p1[i] = (p1[i] > -1e29f) ? __builtin_amdgcn_exp2f(p1[i] - m) : 0.f; rs += p0[i] + p1[i]; }
                l += rs;
                float qs[8], ql[8];
#pragma unroll
                for (int q4 = 0; q4 < 4; ++q4) {
                    qs[q4] = (p0[4 * q4] + p0[4 * q4 + 1]) + (p0[4 * q4 + 2] + p0[4 * q4 + 3]); ql[q4] = p0[4 * q4 + 3];
                    qs[4 + q4] = (p1[4 * q4] + p1[4 * q4 + 1]) + (p1[4 * q4 + 2] + p1[4 * q4 + 3]); ql[4 + q4] = p1[4 * q4 + 3];
                }
                float xl[8];
#pragma unroll
                for (int e = 0; e < 8; ++e) xl[e] = xhalf(ql[e]);
#pragma unroll
                for (int e = 0; e < 8; ++e) qs[e] += hi ? xl[e] : (e > 0 ? xl[e - 1] : carry);
                carry = xl[7];
#pragma unroll
                for (int k2 = 0; k2 < 4; ++k2) if (kt == k2) {
#pragma unroll
                    for (int e = 0; e < 8; ++e) imp[8 * k2 + e] += qs[e]; }
                const bf16x8 pa0 = pack_acc(p0, 0), pa1 = pack_acc(p0, 1), pa2 = pack_acc(p1, 0), pa3 = pack_acc(p1, 1);
                const unsigned char* Vt = Vl + kt * KVTILE;
                o0 = MFMA32(frag_col44(Vt, KVP, 4 * hi, 0, lane), pa0, o0);       o1 = MFMA32(frag_col44(Vt, KVP, 4 * hi, 32, lane), pa0, o1);
                o0 = MFMA32(frag_col44(Vt, KVP, 16 + 4 * hi, 0, lane), pa1, o0);  o1 = MFMA32(frag_col44(Vt, KVP, 16 + 4 * hi, 32, lane), pa1, o1);
                o0 = MFMA32(frag_col44(Vt, KVP, 32 + 4 * hi, 0, lane), pa2, o0);  o1 = MFMA32(frag_col44(Vt, KVP, 32 + 4 * hi, 32, lane), pa2, o1);
                o0 = MFMA32(frag_col44(Vt, KVP, 48 + 4 * hi, 0, lane), pa3, o0);  o1 = MFMA32(frag_col44(Vt, KVP, 48 + 4 * hi, 32, lane), pa3, o1);
            }
            l = xsum_half(l);
            const float inv = 1.0f / fmaxf(l, 1e-30f);
#pragma unroll
            for (int i = 0; i < 16; ++i) { o0[i] *= inv; o1[i] *= inv; }
#pragma unroll
            for (int i = 0; i < 32; ++i) self[i] += imp[i] * inv;
            float* op = OC + (size_t)t * TOKW + hh * 64;
#pragma unroll
            for (int rq = 0; rq < 4; ++rq) { *(f32x4*)(op + 8 * rq + 4 * hi) = (f32x4){o0[4 * rq], o0[4 * rq + 1], o0[4 * rq + 2], o0[4 * rq + 3]};
                *(f32x4*)(op + 32 + 8 * rq + 4 * hi) = (f32x4){o1[4 * rq], o1[4 * rq + 1], o1[4 * rq + 2], o1[4 * rq + 3]}; }
        }
        const int cur = tq >> 6;
        float sc[32];
#pragma unroll
        for (int i = 0; i < 32; ++i) {
            const float imp = self[i];
            const int mblk = 2 * i + hi;
            const bool forced = (mblk == 0) || (mblk == cur) || (mblk == cur - 1);
            sc[i] = mblk <= cur ? (forced ? 1.0e4f : imp) : -1.0f;
        }
        unsigned wlo = 0u, whi = 0u;
#pragma unroll 1
        for (int round = 0; round < 16; ++round) {
            float bv = sc[0]; int bi = 0;
#pragma unroll
            for (int i = 1; i < 32; ++i) { const bool gt = sc[i] > bv; bv = gt ? sc[i] : bv; bi = gt ? i : bi; }
            const int gm = 2 * bi + hi;
            const float pv = xhalf(bv); const int pm = __shfl_xor(gm, 32);
            const bool win = (bv > pv) || (bv == pv && gm < pm);
            if (win && bv >= 0.f) { if (gm < 32) wlo |= 1u << gm; else whi |= 1u << (gm - 32); }
#pragma unroll
            for (int i = 0; i < 32; ++i) sc[i] = (win && i == bi) ? -2.0f : sc[i];
        }
        wlo |= (unsigned)__shfl_xor((int)wlo, 32); whi |= (unsigned)__shfl_xor((int)whi, 32);
        if (hi == 0) SELM[(size_t)t * 4 + g] = ((unsigned long long)whi << 32) | wlo;
    }
}

DI void ln_wave(f32x4 (&v)[4], const float* g, const float* b, int lane) {
    float s = 0.f;
#pragma unroll
    for (int j = 0; j < 4; ++j) s += (v[j][0] + v[j][1]) + (v[j][2] + v[j][3]);
    const float mean = wave_sum(s) * (1.0f / D); float s2 = 0.f;
#pragma unroll
    for (int j = 0; j < 4; ++j) { v[j] = v[j] - mean; s2 += (v[j][0] * v[j][0] + v[j][1] * v[j][1]) + (v[j][2] * v[j][2] + v[j][3] * v[j][3]); }
    const float rstd = 1.0f / sqrtf(wave_sum(s2) * opq(1.0f / D) + opq(LN_EPS));
#pragma unroll
    for (int j = 0; j < 4; ++j) { const f32x4 gv = ((const f32x4*)g)[lane + 64 * j], bv = ((const f32x4*)b)[lane + 64 * j]; v[j] = v[j] * rstd * gv + bv; }
}
DI void phase_moe_route(const Args& a, Frame& F, int L) {
    enter(F);
    const bf16* Z = (const bf16*)(F.ws + WS_Z); bf16* X1B = (bf16*)(F.ws + WS_X1B);
    int* TOKE = (int*)(F.ws + WS_TOKE); float* TOKG = (float*)(F.ws + WS_TOKG); int* TOKL = (int*)(F.ws + WS_TOKL);
    unsigned* gcnt = (unsigned*)(F.ws + WS_CTL) + CW_CNT + 64 * L;
    const float* g1 = a.in[I_LN1G] + (size_t)L * D, *b1 = a.in[I_LN1B] + (size_t)L * D;
    const float* rw = a.in[I_RTW] + (size_t)L * D * NE, *rb = a.in[I_RTB] + (size_t)L * NE;
    constexpr int XP = 1028;
    float* xs = (float*)F.lds;
    float* part = (float*)(F.lds + 65792);
    int* lrank = (int*)(F.lds + 65792 + 16384);
    int* lexp = lrank + 64;
    int* hist = (int*)(F.lds + MISC_OFF + MS_HIST); int* base = (int*)(F.lds + MISC_OFF + MS_BASE);
    const int lane = F.lane, wv = F.wave;
    { int* RTK = (int*)(F.ws + WS_ROWTOK); for (int blk = F.bid; blk < MOEROWS / 512; blk += F.G) RTK[blk * 512 + F.tid] = 0; }
    float bw[32][2];
#pragma unroll
    for (int ks = 0; ks < 32; ++ks)
#pragma unroll
        for (int eh = 0; eh < 2; ++eh) bw[ks][eh] = rw[(size_t)(128 * wv + 4 * ks + (lane >> 4)) * NE + 16 * eh + (lane & 15)];
    v2u zn[2][4];
    if (F.bid < T / 16) {
#pragma unroll
        for (int rr = 0; rr < 2; ++rr)
#pragma unroll
            for (int j = 0; j < 4; ++j) zn[rr][j] = ((const v2u*)(Z + (size_t)(F.bid * 16 + wv * 2 + rr) * D))[lane + 64 * j]; }
    for (int tile = F.bid; tile < T / 16; tile += F.G) {
        const int t0 = tile * 16;
        lds_barrier();
        if (F.tid < 32) hist[F.tid] = 0;
#pragma unroll
        for (int rr = 0; rr < 2; ++rr) { const int tk = wv * 2 + rr, t = t0 + tk;
            f32x4 v[4];
#pragma unroll
            for (int j = 0; j < 4; ++j) { const v2u z = zn[rr][j]; v[j] = (f32x4){__builtin_bit_cast(float, z.x << 16), __builtin_bit_cast(float, z.x & 0xffff0000u), __builtin_bit_cast(float, z.y << 16), __builtin_bit_cast(float, z.y & 0xffff0000u)}; }
            ln_wave(v, g1, b1, lane);
#pragma unroll
            for (int j = 0; j < 4; ++j) { *(f32x4*)(xs + tk * XP + 4 * (lane + 64 * j)) = v[j];
                v2u o; o.x = pk2(v[j][0], v[j][1]); o.y = pk2(v[j][2], v[j][3]); ((v2u*)(X1B + (size_t)t * D))[lane + 64 * j] = o; } }
        if (tile + F.G < T / 16) {
#pragma unroll
            for (int rr = 0; rr < 2; ++rr)
#pragma unroll
                for (int j = 0; j < 4; ++j) zn[rr][j] = ((const v2u*)(Z + (size_t)((tile + F.G) * 16 + wv * 2 + rr) * D))[lane + 64 * j]; }
        lds_barrier();
        {
            f32x4 c0 = {0.f, 0.f, 0.f, 0.f}, c1 = {0.f, 0.f, 0.f, 0.f};
            const float* ap = xs + (lane & 15) * XP + 128 * wv + (lane >> 4);
#pragma unroll
            for (int ks = 0; ks < 32; ++ks) { const float av = ap[4 * ks];
                c0 = __builtin_amdgcn_mfma_f32_16x16x4f32(av, bw[ks][0], c0, 0, 0, 0); c1 = __builtin_amdgcn_mfma_f32_16x16x4f32(av, bw[ks][1], c1, 0, 0, 0); }
#pragma unroll
            for (int r = 0; r < 4; ++r) { const int tok = (lane >> 4) * 4 + r; part[(wv * 16 + tok) * 32 + (lane & 15)] = c0[r]; part[(wv * 16 + tok) * 32 + 16 + (lane & 15)] = c1[r]; }
        }
        lds_barrier();
        const int tk = F.tid >> 5, e = F.tid & 31, t = t0 + tk;
        float lg = rb[e];
#pragma unroll
        for (int w8 = 0; w8 < 8; ++w8) lg += part[(w8 * 16 + tk) * 32 + e];
        float tv[4]; int ti[4];
        { float* lgl = (float*)(F.lds + 82688); float* tvs = (float*)(F.lds + 84736); unsigned* tis = (unsigned*)(F.lds + 84992);
          lgl[tk * 32 + e] = lg;
          int rank = 0;
#pragma unroll
          for (int k4 = 0; k4 < 8; ++k4) { const f32x4 v = *(const f32x4*)(lgl + tk * 32 + 4 * k4);
#pragma unroll
              for (int d = 0; d < 4; ++d) { const int k = 4 * k4 + d; rank += (v[d] > lg || (v[d] == lg && k < e)) ? 1 : 0; } }
          if (rank < 4) { tvs[tk * 4 + rank] = lg; tis[tk * 4 + rank] = (unsigned)e; }
          const f32x4 tv4 = *(const f32x4*)(tvs + tk * 4); const v4u ti4 = *(const v4u*)(tis + tk * 4);
          tv[0] = tv4[0]; tv[1] = tv4[1]; tv[2] = tv4[2]; tv[3] = tv4[3]; ti[0] = (int)ti4.x; ti[1] = (int)ti4.y; ti[2] = (int)ti4.z; ti[3] = (int)ti4.w; }
        const float e0 = 1.0f, e1 = expf(tv[1] - tv[0]), e2 = expf(tv[2] - tv[0]), e3 = expf(tv[3] - tv[0]);
        const float inv = 1.0f / (e0 + e1 + e2 + e3);
        if (e < 4) { const int myi = e == 0 ? ti[0] : e == 1 ? ti[1] : e == 2 ? ti[2] : ti[3]; const float myg = (e == 0 ? e0 : e == 1 ? e1 : e == 2 ? e2 : e3) * inv;
            TOKE[(size_t)t * 4 + e] = myi; TOKG[(size_t)t * 4 + e] = myg;
            lrank[tk * 4 + e] = atomicAdd(&hist[myi], 1); lexp[tk * 4 + e] = myi; }
        lds_barrier();
        if (F.tid < 32) base[F.tid] = (int)atomicAdd(&gcnt[F.tid], (unsigned)hist[F.tid]);
        lds_barrier();
        if (F.tid < 64) TOKL[(size_t)t0 * 4 + F.tid] = base[lexp[F.tid]] + lrank[F.tid];
    }
}
DI void moe_tables(Frame& F, int L) {
    enter(F);
    const unsigned* gcnt = (const unsigned*)(F.ws + WS_CTL) + CW_CNT + 64 * L;
    int* pads = (int*)(F.lds + MISC_OFF + MS_PADS); int* nbp = (int*)(F.lds + MISC_OFF + MS_NB); unsigned char* bexp = F.lds + MISC_OFF + MS_BEXP;
    __syncthreads();
    if (F.tid < 64) {
        const int e = F.tid, c = e < NE ? (int)__hip_atomic_load(&gcnt[e], __ATOMIC_RELAXED, __HIP_MEMORY_SCOPE_AGENT) : 0, p = (c + 255) / 256 * 256;
        int sfx = p;
#pragma unroll
        for (int o = 1; o < 32; o <<= 1) { const int up = __shfl_up(sfx, o, 32); if ((e & 31) >= o) sfx += up; }
        if (e < NE) pads[e] = sfx - p;
        if (e == NE - 1) { pads[NE] = sfx; nbp[0] = sfx / 256; } }
    __syncthreads();
    for (int bI = F.tid; bI < NBMAX; bI += 512) { const int row = bI * 256;
        int ee = 0; for (int k = 0; k < NE; ++k) if (pads[k] <= row && pads[k + 1] > row) ee = k;
        bexp[bI] = (unsigned char)ee; }
    __syncthreads();
}
DI void phase_moe_gather(Frame& F, int L) {
    moe_tables(F, L);
    const int* pads = (const int*)(F.lds + MISC_OFF + MS_PADS);
    const int* TOKE = (const int*)(F.ws + WS_TOKE); const int* TOKL = (const int*)(F.ws + WS_TOKL); int* TOKS = (int*)(F.ws + WS_TOKS); int* RTK = (int*)(F.ws + WS_ROWTOK);
    for (int blk = F.bid; blk < T * 4 / 512; blk += F.G) { const int i = blk * 512 + F.tid; const int slot = pads[TOKE[i]] + TOKL[i]; TOKS[i] = slot; RTK[slot] = i >> 2; }
}
DI void moe_rowtab(Frame& F, int nN) {
    const int NB = *(const int*)(F.lds + MISC_OFF + MS_NB); const int* RTK = (const int*)(F.ws + WS_ROWTOK);
    unsigned short* rt = (unsigned short*)(F.lds + MISC_OFF + MS_RT);
    int tok[17];
#pragma unroll
    for (int i = 0; i < 17; ++i) { const int x = F.bid & 7, q = i * (F.G >> 3) + (F.bid >> 3), chunk = (NB + 7) >> 3, r = q / nN, pm = x * chunk + r;
        tok[i] = (r < chunk && pm < NB && F.tid < 256) ? RTK[pm * 256 + F.tid] : -1; }
#pragma unroll
    for (int i = 0; i < 17; ++i) if (tok[i] >= 0) rt[i * 256 + F.tid] = (unsigned short)tok[i];
    __syncthreads();
}
DI void phase_moe_combine(const Args& a, Frame& F, int L) {
    enter(F);
    const bf16* Y = (const bf16*)(F.ws + WS_Y); const bf16* X1B = (const bf16*)(F.ws + WS_X1B);
    const int* TOKS = (const int*)(F.ws + WS_TOKS); const float* TOKG = (const float*)(F.ws + WS_TOKG);
    bf16* XB = (bf16*)(F.ws + WS_XB);
    const float* g2 = a.in[I_LN2G] + (size_t)L * D, *b2 = a.in[I_LN2B] + (size_t)L * D;
    const int gw = F.bid * 8 + F.wave, NGW = F.G * 8;
    for (int t0 = gw * 2; t0 < T; t0 += NGW * 2) {
        int slot[2][4]; float gt[2][4];
#pragma unroll
        for (int q = 0; q < 2; ++q)
#pragma unroll
            for (int k = 0; k < 4; ++k) { slot[q][k] = TOKS[(size_t)(t0 + q) * 4 + k]; gt[q][k] = TOKG[(size_t)(t0 + q) * 4 + k]; }
        v4u xr[2][2], yr[2][4][2];
#pragma unroll
        for (int q = 0; q < 2; ++q) {
            xr[q][0] = ((const v4u*)(X1B + (size_t)(t0 + q) * D))[F.lane]; xr[q][1] = ((const v4u*)(X1B + (size_t)(t0 + q) * D))[F.lane + 64];
#pragma unroll
            for (int k = 0; k < 4; ++k) { yr[q][k][0] = ((const v4u*)(Y + (size_t)slot[q][k] * D))[F.lane]; yr[q][k][1] = ((const v4u*)(Y + (size_t)slot[q][k] * D))[F.lane + 64]; } }
#pragma unroll
        for (int q = 0; q < 2; ++q) {
            const int t = t0 + q;
            float v[16];
#pragma unroll
            for (int h = 0; h < 2; ++h)
#pragma unroll
                for (int e = 0; e < 4; ++e) { const unsigned wv = xr[q][h][e]; v[8 * h + 2 * e] = __builtin_bit_cast(float, wv << 16) * DEEP_ALPHA; v[8 * h + 2 * e + 1] = __builtin_bit_cast(float, wv & 0xffff0000u) * DEEP_ALPHA; }
#pragma unroll
            for (int k = 0; k < 4; ++k)
#pragma unroll
                for (int h = 0; h < 2; ++h)
#pragma unroll
                    for (int e = 0; e < 4; ++e) { const unsigned wv = yr[q][k][h][e]; v[8 * h + 2 * e] += __builtin_bit_cast(float, wv << 16) * gt[q][k]; v[8 * h + 2 * e + 1] += __builtin_bit_cast(float, wv & 0xffff0000u) * gt[q][k]; }
            float s = 0.f;
#pragma unroll
            for (int i = 0; i < 16; ++i) s += v[i];
            const float mean = wave_sum(s) * (1.0f / D); float s2 = 0.f;
#pragma unroll
            for (int i = 0; i < 16; ++i) { v[i] -= mean; s2 += v[i] * v[i]; }
            const float rstd = 1.0f / sqrtf(wave_sum(s2) * opq(1.0f / D) + opq(LN_EPS));
#pragma unroll
            for (int h = 0; h < 2; ++h) {
                const int c0 = 512 * h + 8 * F.lane;
                const f32x4 ga = *(const f32x4*)(g2 + c0), gb = *(const f32x4*)(g2 + c0 + 4), ba = *(const f32x4*)(b2 + c0), bb = *(const f32x4*)(b2 + c0 + 4);
                float o[8];
#pragma unroll
                for (int e = 0; e < 4; ++e) { o[e] = v[8 * h + e] * rstd * ga[e] + ba[e]; o[4 + e] = v[8 * h + 4 + e] * rstd * gb[e] + bb[e]; }
                if (L == DEPTH - 1) { *(f32x4*)(a.out + (size_t)t * D + c0) = (f32x4){o[0], o[1], o[2], o[3]}; *(f32x4*)(a.out + (size_t)t * D + c0 + 4) = (f32x4){o[4], o[5], o[6], o[7]}; }
                v4u w; w.x = pk2(o[0], o[1]); w.y = pk2(o[2], o[3]); w.z = pk2(o[4], o[5]); w.w = pk2(o[6], o[7]);
                *(v4u*)(XB + (size_t)t * D + c0) = w;
            }
        }
    }
}

DI bool in_range(int k, int lo, int hi) { asm volatile("" : "+s"(lo), "+s"(hi)); return lo <= k && k < hi; }
constexpr int PH_PER_LAYER = 12, NPHASES = 1 + DEPTH * PH_PER_LAYER;
__global__ void __launch_bounds__(512, 2) fwd(Args a) {
    extern __shared__ __attribute__((aligned(16))) unsigned char lds[];
    Frame F;
    F.lds = lds; F.ws = a.ws; F.tid = threadIdx.x; F.lane = F.tid & 63; F.wave = __builtin_amdgcn_readfirstlane(F.tid >> 6); F.G = gridDim.x; F.bid = blockIdx.x;
    if (F.tid < 4) ((unsigned*)(lds + MISC_OFF + MS_BAR))[F.tid] = 0u;
    __syncthreads();
    const int lo = a.ph_lo, hi = a.ph_hi;
    const bool multi = (hi - lo) > 1;
    XcdBarrier bar; bar.bar = (unsigned*)(a.ws + WS_CTL) + CW_BAR; bar.x = 0; bar.st = (volatile LAS unsigned*)(LAS unsigned char*)(lds + MISC_OFF + MS_BAR); bar.wave = F.wave;
    if (multi) { bar = xcd_barrier_post((unsigned*)(a.ws + WS_CTL) + CW_BAR, (volatile LAS unsigned*)(LAS unsigned char*)(lds + MISC_OFF + MS_BAR)); bar.wave = F.wave; }
#define IN(k) in_range((k), lo, hi)
#define SEAM(k) do { if (IN((k) + 1)) xcd_barrier(bar); } while (0)
#define REP(bit) for (int rep_ = 0; rep_ <= ((a.probe >> (bit)) & 1); ++rep_)
    PG8_LAS unsigned char* ring = (PG8_LAS unsigned char*)lds;

    if (IN(0)) { REP(0) phase_prologue(a, F); SEAM(0); }
    for (int L = 0; L < DEPTH; ++L) {
        const int kind = L % 3, j = L / 3, p0 = 1 + L * PH_PER_LAYER;
        if (hi <= p0 || lo >= p0 + PH_PER_LAYER) continue;
        const int mq = kind == 0 ? NMQ : kind == 1 ? GMQ : RMQ;
        if (IN(p0)) { REP(1) {
            { enter(F); pg8::SchedDense S; S.init(a.ws + WS_XB, a.ws + WS_WIN + (size_t)L * WIN_STRIDE, T, HC, D, F.G, F.bid);
              pg8::EpiBf16P E{(bf16*)(a.ws + WS_HB), HC}; pg8::gemm_phase<pg8::EpiBf16P, pg8::SchedDense, true, true>(ring, D, S, E, F.wave); }
            { enter(F); pg8::SchedDense S; S.init(a.ws + WS_MEMB, a.ws + WS_WKV + (size_t)L * 512 * D * 2, BATCH * MEMLEN, 512, D, F.G, F.G - 1 - F.bid);
              pg8::EpiBf16P E{(bf16*)(a.ws + WS_KVB), 512}; pg8::gemm_phase<pg8::EpiBf16P, pg8::SchedDense, true, true>(ring, D, S, E, F.wave); } }
            SEAM(p0);
        }
        if (kind == 0) {
            if (IN(p0 + 1)) { REP(2) phase_nsa_cmpA(a, F, j); SEAM(p0 + 1); }
            if (IN(p0 + 2)) { REP(2) { enter(F); pg8::SchedPair S{(const char*)(a.ws + MX_CMPA), (const char*)(a.ws + WS_CW1 + (size_t)j * 2 * 256 * 2048 * 2), (size_t)8192 * 2048 * 2, (size_t)256 * 2048 * 2, 2048, 32, 1, F.G, F.bid};
                pg8::EpiBf16Gelu E{(bf16*)(a.ws + MX_CMPH), 256, (size_t)8192 * 256}; pg8::gemm_phase<pg8::EpiBf16Gelu, pg8::SchedPair, true, true>(ring, 2048, S, E, F.wave);
                  asm volatile("s_waitcnt vmcnt(0)" ::: "memory"); __syncthreads();
                  phase_nsa_cmp2(F, j, true); }
                REP(9) phase_memattn_mfma(F, mq, 64);
                SEAM(p0 + 2); }
            if (IN(p0 + 4)) { REP(3) phase_nsa_cmpattn_mfma(a, F); SEAM(p0 + 4); }
            if (IN(p0 + 5)) { REP(4) phase_nsa_selwin_mfma(a, F, j); SEAM(p0 + 5); }
        } else if (kind == 1) {
            if (IN(p0 + 1)) { REP(5) phase_gla_prep(a, F); SEAM(p0 + 1); }
            if (IN(p0 + 2)) { REP(16) phase_gla_seq(F); REP(15) phase_gla_intra(F, BATCH * 4); REP(9) phase_memattn_mfma(F, mq, BATCH * 4); SEAM(p0 + 2); }
            if (IN(p0 + 4)) { REP(19) phase_gla_out2(a, F); SEAM(p0 + 4); }
        } else {
            if (IN(p0 + 1)) { REP(7) phase_rwkv_lo(a, F); SEAM(p0 + 1); }
            if (IN(p0 + 2)) { REP(7) { enter(F); pg8::SchedDense S; S.init(a.ws + MX_RLO, a.ws + WS_WLORA, T, 2304, 256, F.G, F.bid);
                pg8::EpiBf16P E{(bf16*)(a.ws + MX_RLORA), 2304}; pg8::gemm_phase<pg8::EpiBf16P, pg8::SchedDense, true, true>(ring, 256, S, E, F.wave); } SEAM(p0 + 2); }
            if (IN(p0 + 3)) { REP(6) phase_rwkv_chunk(a, F); SEAM(p0 + 3); }
            if (IN(p0 + 4)) { REP(8) phase_rwkv_seq(F); REP(9) phase_memattn_mfma(F, mq, BATCH * 12); SEAM(p0 + 4); }
            if (IN(p0 + 5)) { REP(7) phase_rwkv_out(a, F); SEAM(p0 + 5); }
        }
        if (IN(p0 + 6)) { REP(10) { enter(F);
            pg8::SchedDense S; S.init(a.ws + WS_CAT, a.ws + WS_WOUT + (size_t)L * D * D * 2, T, D, D, F.G, F.bid);
            pg8::EpiResid E{(const bf16*)(a.ws + WS_XB), (bf16*)(a.ws + WS_Z), D, DEEP_ALPHA};
            pg8::gemm_phase<pg8::EpiResid, pg8::SchedDense, true, true>(ring, D, S, E, F.wave); } SEAM(p0 + 6);
        }
        if (IN(p0 + 7)) { phase_moe_route(a, F, L); SEAM(p0 + 7); }
        if (IN(p0 + 8)) { REP(11) phase_moe_gather(F, L); SEAM(p0 + 8); }
        if (IN(p0 + 9)) { REP(12) { if (a.ph_lo > p0 + 8) moe_tables(F, L); else enter(F);
            moe_rowtab(F, 8);
            pg8::SchedMoeG S{(const char*)(a.ws + WS_X1B), (const char*)(a.ws + WS_WGU + (size_t)L * NE * 2048 * D * 2), (const PG8_LAS unsigned char*)(lds + MISC_OFF + MS_BEXP), (const PG8_LAS unsigned short*)(lds + MISC_OFF + MS_RT), *(const int*)(lds + MISC_OFF + MS_NB), D, 8, 2048, F.G, F.bid};
            pg8::EpiSwiglu E{(bf16*)(a.ws + WS_ACT), a.in[I_BGU] + (size_t)L * NE * 2048};
            pg8::gemm_phase<pg8::EpiSwiglu, pg8::SchedMoeG, true, true>(ring, D, S, E, F.wave); } SEAM(p0 + 9); }
        if (IN(p0 + 10)) { REP(13) { if (a.ph_lo > p0 + 8) moe_tables(F, L); else enter(F);
            pg8::SchedMoe S{(const char*)(a.ws + WS_ACT), (const char*)(a.ws + WS_WDN + (size_t)L * NE * D * D * 2), (const PG8_LAS unsigned char*)(lds + MISC_OFF + MS_BEXP), *(const int*)(lds + MISC_OFF + MS_NB), D, 4, 1024, F.G, F.bid};
            pg8::EpiDown E{(bf16*)(a.ws + WS_Y), a.in[I_BDN] + (size_t)L * NE * D};
            pg8::gemm_phase<pg8::EpiDown, pg8::SchedMoe, true, true>(ring, D, S, E, F.wave); } SEAM(p0 + 10); }
        if (IN(p0 + 11)) { REP(14) phase_moe_combine(a, F, L); SEAM(p0 + 11); }
    }
#undef IN
#undef SEAM
}

extern "C" void kernel_launch(void* const* d_in, const int* in_sizes, int n_in, void* d_out, int out_size, void* d_ws, size_t ws_size, hipStream_t stream) {
    static int grid = 0;
    if (grid == 0) {
        if (n_in != 37 || out_size != T * D || ws_size < WS_END) { fprintf(stderr, "kernel_launch: unexpected problem (n_in %d, out %d, ws %zu); nothing launched\n", n_in, out_size, ws_size); grid = -1; return; }
        int dev = 0, cus = 0;
        if (hipGetDevice(&dev) != hipSuccess || hipDeviceGetAttribute(&cus, hipDeviceAttributeMultiprocessorCount, dev) != hipSuccess) { grid = -1; return; }
        if (hipFuncSetAttribute((const void*)fwd, hipFuncAttributeMaxDynamicSharedMemorySize, LDS_BYTES) != hipSuccess) { fprintf(stderr, "kernel_launch: hipFuncSetAttribute failed\n"); grid = -1; return; }
        int per_cu = 0;
        if (hipOccupancyMaxActiveBlocksPerMultiprocessor(&per_cu, (const void*)fwd, 512, LDS_BYTES) != hipSuccess || per_cu < 1) fprintf(stderr, "kernel_launch: occupancy query reports %d\n", per_cu);
        (void)hipGetLastError();
        grid = cus;
    }
    if (grid < 0) return;
    if (hipMemsetAsync((char*)d_ws + WS_CTL, 0, CTL_BYTES, stream) != hipSuccess) return;
    Args a{};
    for (int i = 0; i < 37; ++i) a.in[i] = (const float*)d_in[i];
    a.out = (float*)d_out; a.ws = (unsigned char*)d_ws;
#ifndef PROBE_MASK
#define PROBE_MASK 0
#endif
    a.probe = PROBE_MASK; a.pad = 0;
#ifndef ONE_LAUNCH
#define ONE_LAUNCH 1
#endif
    if (ONE_LAUNCH) {
        a.ph_lo = 0; a.ph_hi = NPHASES;
        hipLaunchKernelGGL(fwd, dim3(grid), dim3(512), LDS_BYTES, stream, a);
    } else {
        for (int p = 0; p < NPHASES; ++p) {
            if (p > 0) { const int L = (p - 1) / PH_PER_LAYER, k = (p - 1) % PH_PER_LAYER, kind = L % 3; if (kind == 1 && k == 5) continue; }
            a.ph_lo = p; a.ph_hi = p + 1;
            hipLaunchKernelGGL(fwd, dim3(grid), dim3(512), LDS_BYTES, stream, a);
        }
    }
}
```

```cpp
#include <hip/hip_runtime.h>
#include <cstdio>
#include <cstdint>

#define DI __device__ __forceinline__
typedef unsigned short bf16;
typedef unsigned v4u __attribute__((ext_vector_type(4)));
typedef unsigned v2u __attribute__((ext_vector_type(2)));
typedef float f32x4 __attribute__((ext_vector_type(4)));
typedef float f32x2 __attribute__((ext_vector_type(2)));

constexpr int D = 1024, BATCH = 8, SEQ = 4096, T = BATCH * SEQ, DEPTH = 4;
constexpr int HC = 2816;
constexpr int MEMLEN = 256, MEMW = 256, TOKW = 768;
constexpr int NSA_COLS = 2596, GLA_COLS = 2576, RWKV_COLS = 2816;
constexpr int NE = 32, TOPK = 4, NBMAX = 544, MOEROWS = NBMAX * 256;
constexpr int NC = 255;
constexpr float DEEP_ALPHA = 1.6817928305074292f;
constexpr float LN_EPS = 1e-5f;
constexpr int NQ = 0, NKC = 768, NVC = 1024, NKS = 1280, NVS = 1536, NKW = 1792, NVW = 2048, NGL = 2304, NMQ = 2340;
constexpr int GQ = 0, GK = 384, GV = 768, GALR = 1536, GOG = 1552, GMQ = 2320;
constexpr int RR = 0, RWL = 768, RK = 832, RV = 1600, RAL = 2368, RGL = 2432, RMQ = 2560;

constexpr size_t MiB = 1u << 20;
constexpr size_t WS_CTL = 0, CTL_BYTES = 1 * MiB;
constexpr size_t WS_WIN = 2 * MiB;
constexpr size_t WIN_STRIDE = 6 * MiB;
constexpr size_t WS_WOUT = 26 * MiB;
constexpr size_t WS_WKV = 34 * MiB;
constexpr size_t WS_CW1 = 38 * MiB;
constexpr size_t WS_CW2T = 44 * MiB;
constexpr size_t WS_WGU = 64 * MiB;
constexpr size_t WS_WDN = 576 * MiB;
constexpr size_t WS_XF = 832 * MiB;
constexpr size_t WS_XB = 960 * MiB;
constexpr size_t WS_H = 1024 * MiB;
constexpr size_t WS_CAT = 1376 * MiB;
constexpr size_t WS_Z = 1440 * MiB;
constexpr size_t WS_X1F = 1568 * MiB;
constexpr size_t WS_X1B = 1696 * MiB;
constexpr size_t WS_TOKE = 1760 * MiB;
constexpr size_t WS_TOKG = WS_TOKE + 512 * 1024;
constexpr size_t WS_TOKL = WS_TOKG + 512 * 1024;
constexpr size_t WS_TOKS = WS_TOKL + 512 * 1024;
constexpr size_t WS_MEMB = 1762 * MiB;
constexpr size_t WS_ROWTOK = 1766 * MiB;
constexpr size_t WS_XG = 1776 * MiB;
constexpr size_t WS_ACT = 2048 * MiB;
constexpr size_t WS_Y = 2320 * MiB;
constexpr size_t WS_MIX = 2864 * MiB;
constexpr size_t WS_HB = 3664 * MiB;
constexpr size_t WS_KVB = 3840 * MiB;
constexpr size_t WS_END = 3842 * MiB;
constexpr size_t MX_CMPA = WS_MIX;
constexpr size_t MX_CMPH = WS_MIX + 64 * MiB;
constexpr size_t MX_KC = WS_MIX + 80 * MiB;
constexpr size_t MX_VC = WS_MIX + 84 * MiB;
constexpr size_t MX_OC = WS_MIX + 88 * MiB;
constexpr size_t MX_SELM = WS_MIX + 184 * MiB;
constexpr size_t MX_KCB = WS_MIX + 186 * MiB;
constexpr size_t MX_VCB = WS_MIX + 188 * MiB;
constexpr size_t MX_OSB = WS_MIX + 190 * MiB;
constexpr size_t MX_GDEC = WS_MIX;
constexpr size_t MX_GO = WS_MIX + 48 * MiB;
constexpr size_t MX_RV0 = WS_MIX;
constexpr size_t MX_RO = WS_MIX + 672 * MiB;
constexpr size_t MX_RBON = WS_MIX + 768 * MiB;
constexpr int CW_BAR = 4096;
constexpr int CW_CNT = 1024;

constexpr int RING_BYTES = 131072, MISC_OFF = 131072, LDS_BYTES = 147456;
constexpr int MS_BAR = 0;
constexpr int MS_NB = 32;
constexpr int MS_PADS = 64;
constexpr int MS_BEXP = 256;
constexpr int MS_HIST = 1024;
constexpr int MS_BASE = 1152;
constexpr int MS_RT = 2048;

__device__ const unsigned char T5B[128] = {0, 1, 2, 3, 4, 5, 6, 7, 8, 9, 10, 11, 12, 13, 14, 15, 16, 16, 16, 17, 17, 18, 18, 18, 19, 19, 19, 20, 20, 20, 20, 21, 21, 21, 21, 22, 22, 22, 22, 22, 23, 23, 23, 23, 23, 23, 24, 24, 24, 24, 24, 24, 25, 25, 25, 25, 25, 25, 25, 26, 26, 26, 26, 26, 26, 26, 26, 27, 27, 27, 27, 27, 27, 27, 27, 27, 27, 28, 28, 28, 28, 28, 28, 28, 28, 28, 28, 29, 29, 29, 29, 29, 29, 29, 29, 29, 29, 29, 29, 30, 30, 30, 30, 30, 30, 30, 30, 30, 30, 30, 30, 30, 30, 31, 31, 31, 31, 31, 31, 31, 31, 31, 31, 31, 31, 31, 31, 31};
DI int t5_bucket(int dist) { return dist >= 128 ? 31 : T5B[dist < 0 ? 0 : dist]; }

typedef __bf16 bf16x2_hw __attribute__((ext_vector_type(2)));
DI unsigned pk2(float lo, float hi) { f32x2 v = {lo, hi}; bf16x2_hw b = __builtin_convertvector(v, bf16x2_hw); return __builtin_bit_cast(unsigned, b); }
DI unsigned f2bf(float f) { return pk2(f, 0.f) & 0xffffu; }
DI float bf2f(unsigned short b) { return __builtin_bit_cast(float, ((unsigned)b) << 16); }
DI float opq(float c) { asm volatile("" : "+v"(c)); return c; }
DI void lds_barrier() { asm volatile("s_waitcnt lgkmcnt(0)" ::: "memory"); __builtin_amdgcn_s_barrier(); asm volatile("" ::: "memory"); }
template <int CTRL> DI float dppf(float v) { return __builtin_bit_cast(float, __builtin_amdgcn_update_dpp(0, __builtin_bit_cast(int, v), CTRL, 0xf, 0xf, false)); }
DI float row_sum16(float v) {
    v += dppf<0x128>(v); v += dppf<0x124>(v); v += dppf<0x122>(v); v += dppf<0x121>(v); return v; }
DI float wave_sum(float v) {
    v = row_sum16(v); const int b = __builtin_bit_cast(int, v);
    const float r0 = __builtin_bit_cast(float, __builtin_amdgcn_readlane(b, 0)), r1 = __builtin_bit_cast(float, __builtin_amdgcn_readlane(b, 16));
    const float r2 = __builtin_bit_cast(float, __builtin_amdgcn_readlane(b, 32)), r3 = __builtin_bit_cast(float, __builtin_amdgcn_readlane(b, 48));
    return (r0 + r1) + (r2 + r3); }
DI float wave_max(float v) {
#pragma unroll
    for (int o = 1; o < 64; o <<= 1) v = fmaxf(v, __shfl_xor(v, o));
    return v;
}
DI float sigmoidf_(float x) { return 1.0f / (1.0f + __expf(-x)); }
DI float softplusf_(float x) { return fmaxf(x, 0.f) + log1pf(__expf(-fabsf(x))); }
DI float fexp(float x) { return __builtin_amdgcn_exp2f(x * 1.4426950408889634f); }
DI float flog(float x) { return __builtin_amdgcn_logf(x) * 0.6931471805599453f; }
DI float frcp(float x) { return __builtin_amdgcn_rcpf(x); }
DI float fsigmoid(float x) { return frcp(1.0f + fexp(-x)); }
DI float ftanh(float x) { return 1.0f - 2.0f * frcp(1.0f + fexp(2.0f * x)); }
DI float fsoftplus(float x) { return fmaxf(x, 0.f) + flog(1.0f + fexp(-fabsf(x))); }
DI float gelu_tanh(float x) { const float u = 0.7978845608028654f * (x + 0.044715f * x * x * x); return x * frcp(1.0f + fexp(-2.0f * u)); }

namespace pg8 {
#define PG8_LAS __attribute__((address_space(3)))
typedef unsigned short bf16_t;
typedef short bf16x8 __attribute__((ext_vector_type(8)));
typedef float f32x4 __attribute__((ext_vector_type(4)));
typedef unsigned u32x4 __attribute__((ext_vector_type(4)));
constexpr int BM = 256, BK = 64, HALF = 128, HTB = HALF * BK * 2  , STAGE_BYTES = 8 * HTB, NXCD = 8, WGM = 8;

__host__ __device__ __forceinline__ int lds_byte(int r, int c) { const int st = (r >> 4) * 2 + (c >> 5), rr = r & 15, cc = c & 31, ob = rr * 64 + cc * 2; return st * 1024 + (ob ^ (((ob >> 9) & 1) << 5)); }
__host__ __device__ __forceinline__ void stage_rc(int b, int& R, int& C) { const int st = b / 1024, sb = b % 1024, swz = sb ^ (((sb >> 9) & 1) << 5); R = (st >> 1) * 16 + swz / 64; C = (st & 1) * 32 + (swz % 64) / 2; }
__host__ __device__ __forceinline__ int perm32(int rho) { const int n = rho >> 4, i = rho & 15; return 8 * (i >> 2) + 4 * n + (i & 3); }

struct Unit { int pm, pn, e; };

struct SchedDense {
    static constexpr bool GATHER = false; __device__ __forceinline__ unsigned arow(int, int) const { return 0u; }
    const char* A; const char* Bt; int K, nM, nN, nwg, G, c;
    __device__ void init(const void* A_, const void* Bt_, int M, int N, int K_, int G_, int c_) { A = (const char*)A_; Bt = (const char*)Bt_; K = K_; nM = M / BM; nN = N / BM; nwg = nM * nN; G = G_; c = c_; }
    __device__ __forceinline__ bool next(int i, Unit& u) const {
        const long L = (long)i * G + c; if (L >= nwg) return false;
        int wgid = (int)L; { const int q = nwg / NXCD, r = nwg % NXCD, xcd = wgid % NXCD, off = wgid / NXCD; wgid = (xcd < r ? xcd * (q + 1) : r * (q + 1) + (xcd - r) * q) + off; }
        const int nig = WGM * nN, gid = wgid / nig, fm = gid * WGM, gsz = (nM - fm) < WGM ? (nM - fm) : WGM;
        u.pm = fm + ((wgid % nig) % gsz); u.pn = (wgid % nig) / gsz; u.e = 0; return true;
    }
    __device__ __forceinline__ const char* aptr(const Unit& u) const { return A + (size_t)u.pm * BM * K * 2; }
    __device__ __forceinline__ const char* bptr(const Unit& u) const { return Bt + (size_t)u.pn * BM * K * 2; }
    __device__ __forceinline__ void a_ready(const Unit&) const {}
    __device__ __forceinline__ void done(const Unit&) const {}
};
struct SchedPair {
    static constexpr bool GATHER = false; __device__ __forceinline__ unsigned arow(int, int) const { return 0u; }
    const char* A; const char* Bt; size_t strideA, strideB; int K, nM, nN, G, c;
    __device__ __forceinline__ bool next(int i, Unit& u) const {
        const int L = i * G + c, per = nM * nN; if (L >= 2 * per) return false;
        u.e = L / per; const int r = L % per; u.pm = r / nN; u.pn = r % nN; return true;
    }
    __device__ __forceinline__ const char* aptr(const Unit& u) const { return A + (size_t)u.e * strideA + (size_t)u.pm * BM * K * 2; }
    __device__ __forceinline__ const char* bptr(const Unit& u) const { return Bt + (size_t)u.e * strideB + (size_t)u.pn * BM * K * 2; }
    __device__ __forceinline__ void a_ready(const Unit&) const {}
    __device__ __forceinline__ void done(const Unit&) const {}
};
struct SchedMoe {
    static constexpr bool GATHER = false; __device__ __forceinline__ unsigned arow(int, int) const { return 0u; }
    const char* A; const char* W; const PG8_LAS unsigned char* bexp; int NB, K, nN, N, G, c;
    __device__ __forceinline__ bool next(int i, Unit& u) const {
        const int x = c & 7, q = i * (G >> 3) + (c >> 3), chunk = (NB + 7) >> 3, r = q / nN;
        u.pm = x * chunk + r; u.pn = q % nN; if (r >= chunk || u.pm >= NB) return false;
        u.e = bexp[u.pm]; return true;
    }
    __device__ __forceinline__ const char* aptr(const Unit& u) const { return A + (size_t)u.pm * BM * K * 2; }
    __device__ __forceinline__ const char* bptr(const Unit& u) const { return W + ((size_t)u.e * N + (size_t)u.pn * BM) * K * 2; }
    __device__ __forceinline__ void a_ready(const Unit&) const {}
    __device__ __forceinline__ void done(const Unit&) const {}
};
struct SchedMoeG {
    static constexpr bool GATHER = true;
    const char* A; const char* W; const PG8_LAS unsigned char* bexp; const PG8_LAS unsigned short* rt; int NB, K, nN, N, G, c;
    __device__ __forceinline__ bool next(int i, Unit& u) const {
        const int x = c & 7, q = i * (G >> 3) + (c >> 3), chunk = (NB + 7) >> 3, r = q / nN;
        u.pm = x * chunk + r; u.pn = q % nN; if (r >= chunk || u.pm >= NB) return false;
        u.e = bexp[u.pm]; return true;
    }
    __device__ __forceinline__ unsigned arow(int i, int r) const { return (unsigned)rt[i * 256 + r]; }
    __device__ __forceinline__ const char* aptr(const Unit&) const { return A; }
    __device__ __forceinline__ const char* bptr(const Unit& u) const { return W + ((size_t)u.e * N + (size_t)u.pn * BM) * K * 2; }
    __device__ __forceinline__ void a_ready(const Unit&) const {}
    __device__ __forceinline__ void done(const Unit&) const {}
};

__device__ __forceinline__ unsigned cvt_pk_bf16(float lo, float hi) { unsigned r; asm volatile("v_cvt_pk_bf16_f32 %0, %1, %2" : "=v"(r) : "v"(lo), "v"(hi)); return r; }

template <int ACT> struct EpiF32 {
    static constexpr bool PERM = false, AFTER_DRAIN = false;
    float* C; int ldc; size_t estride;
    __device__ __forceinline__ void operator()(const f32x4 (&acc)[2][2][4][2], const Unit& u, int wr, int wc, int fr, int fq) const {
        const int row0 = u.pm * BM + wr * 64 + fr, col0 = u.pn * BM + wc * 32 + 4 * fq;
        float* Cb = C + (size_t)u.e * estride;
#pragma unroll
        for (int ai = 0; ai < 2; ++ai)
#pragma unroll
            for (int m = 0; m < 4; ++m) { float* rowp = Cb + (size_t)(row0 + ai * HALF + m * 16) * ldc + col0;
#pragma unroll
                for (int bj = 0; bj < 2; ++bj)
#pragma unroll
                    for (int n = 0; n < 2; ++n) { f32x4 v = acc[ai][bj][m][n];
                        if (ACT == 1) { v[0] = gelu_tanh(v[0]); v[1] = gelu_tanh(v[1]); v[2] = gelu_tanh(v[2]); v[3] = gelu_tanh(v[3]); }
                        *(f32x4*)(rowp + bj * HALF + n * 16) = v; } }
    }
};
struct EpiDual {
    static constexpr bool PERM = false, AFTER_DRAIN = false;
    float* C; bf16_t* O; int ldc;
    __device__ __forceinline__ void operator()(const f32x4 (&acc)[2][2][4][2], const Unit& u, int wr, int wc, int fr, int fq) const {
        const int row0 = u.pm * BM + wr * 64 + fr, col0 = u.pn * BM + wc * 32 + 4 * fq;
#pragma unroll
        for (int ai = 0; ai < 2; ++ai)
#pragma unroll
            for (int m = 0; m < 4; ++m) { const size_t off = (size_t)(row0 + ai * HALF + m * 16) * ldc + col0;
#pragma unroll
                for (int bj = 0; bj < 2; ++bj)
#pragma unroll
                    for (int n = 0; n < 2; ++n) { const f32x4 v = acc[ai][bj][m][n];
                        if (C) *(f32x4*)(C + off + bj * HALF + n * 16) = v;
                        typedef unsigned u32x2 __attribute__((ext_vector_type(2))); u32x2 w; w.x = cvt_pk_bf16(v[0], v[1]); w.y = cvt_pk_bf16(v[2], v[3]);
                        *(u32x2*)(O + off + bj * HALF + n * 16) = w; } }
    }
};
struct EpiBf16P {
    static constexpr bool PERM = true, AFTER_DRAIN = false;
    bf16_t* O; int ldc;
    __device__ __forceinline__ void operator()(const f32x4 (&acc)[2][2][4][2], const Unit& u, int wr, int wc, int fr, int fq) const {
        const int row0 = u.pm * BM + wr * 64 + fr, col0 = u.pn * BM + wc * 32 + 8 * fq;
#pragma unroll
        for (int ai = 0; ai < 2; ++ai)
#pragma unroll
            for (int m = 0; m < 4; ++m) { bf16_t* rowp = O + (size_t)(row0 + ai * HALF + m * 16) * ldc + col0;
#pragma unroll
                for (int bj = 0; bj < 2; ++bj) { const f32x4 v0 = acc[ai][bj][m][0], v1 = acc[ai][bj][m][1];
                    u32x4 w; w.x = cvt_pk_bf16(v0[0], v0[1]); w.y = cvt_pk_bf16(v0[2], v0[3]); w.z = cvt_pk_bf16(v1[0], v1[1]); w.w = cvt_pk_bf16(v1[2], v1[3]);
                    *(u32x4*)(rowp + bj * HALF) = w; } }
    }
};
struct EpiBf16Gelu {
    static constexpr bool PERM = true, AFTER_DRAIN = false;
    bf16_t* O; int ldc; size_t estride;
    __device__ __forceinline__ void operator()(const f32x4 (&acc)[2][2][4][2], const Unit& u, int wr, int wc, int fr, int fq) const {
        const int row0 = u.pm * BM + wr * 64 + fr, col0 = u.pn * BM + wc * 32 + 8 * fq;
        bf16_t* Ob = O + (size_t)u.e * estride;
#pragma unroll
        for (int ai = 0; ai < 2; ++ai)
#pragma unroll
            for (int m = 0; m < 4; ++m) { bf16_t* rowp = Ob + (size_t)(row0 + ai * HALF + m * 16) * ldc + col0;
#pragma unroll
                for (int bj = 0; bj < 2; ++bj) { const f32x4 v0 = acc[ai][bj][m][0], v1 = acc[ai][bj][m][1];
                    u32x4 w; w.x = cvt_pk_bf16(gelu_tanh(v0[0]), gelu_tanh(v0[1])); w.y = cvt_pk_bf16(gelu_tanh(v0[2]), gelu_tanh(v0[3])); w.z = cvt_pk_bf16(gelu_tanh(v1[0]), gelu_tanh(v1[1])); w.w = cvt_pk_bf16(gelu_tanh(v1[2]), gelu_tanh(v1[3]));
                    *(u32x4*)(rowp + bj * HALF) = w; } }
    }
};
struct EpiResid {
    static constexpr bool PERM = true, AFTER_DRAIN = false;
    const bf16_t* X; bf16_t* Z; int ldc; float alpha;
    __device__ __forceinline__ void operator()(const f32x4 (&acc)[2][2][4][2], const Unit& u, int wr, int wc, int fr, int fq) const {
        const int row0 = u.pm * BM + wr * 64 + fr, col0 = u.pn * BM + wc * 32 + 8 * fq;
#pragma unroll
        for (int ai = 0; ai < 2; ++ai)
#pragma unroll
            for (int m = 0; m < 4; ++m) { const size_t off = (size_t)(row0 + ai * HALF + m * 16) * ldc + col0;
#pragma unroll
                for (int bj = 0; bj < 2; ++bj) { const u32x4 xr = *(const u32x4*)(X + off + bj * HALF);
                    const f32x4 x0 = {__builtin_bit_cast(float, xr.x << 16), __builtin_bit_cast(float, xr.x & 0xffff0000u), __builtin_bit_cast(float, xr.y << 16), __builtin_bit_cast(float, xr.y & 0xffff0000u)};
                    const f32x4 x1 = {__builtin_bit_cast(float, xr.z << 16), __builtin_bit_cast(float, xr.z & 0xffff0000u), __builtin_bit_cast(float, xr.w << 16), __builtin_bit_cast(float, xr.w & 0xffff0000u)};
                    const f32x4 v0 = x0 * alpha + acc[ai][bj][m][0], v1 = x1 * alpha + acc[ai][bj][m][1];
                    u32x4 w; w.x = cvt_pk_bf16(v0[0], v0[1]); w.y = cvt_pk_bf16(v0[2], v0[3]); w.z = cvt_pk_bf16(v1[0], v1[1]); w.w = cvt_pk_bf16(v1[2], v1[3]);
                    *(u32x4*)(Z + off + bj * HALF) = w; } }
    }
};
struct EpiSwiglu {
    static constexpr bool PERM = true, AFTER_DRAIN = false;
    bf16_t* O; const float* bias;
    __device__ __forceinline__ void operator()(const f32x4 (&acc)[2][2][4][2], const Unit& u, int wr, int wc, int fr, int fq) const {
        const int row0 = u.pm * BM + wr * 64 + fr, c0 = u.pn * HALF + wc * 32 + 8 * fq;
        const float* bg = bias + (size_t)u.e * 2048 + c0; const float* bl = bg + 1024;
        const f32x4 bg0 = *(const f32x4*)bg, bg1 = *(const f32x4*)(bg + 4), bl0 = *(const f32x4*)bl, bl1 = *(const f32x4*)(bl + 4);
#pragma unroll
        for (int ai = 0; ai < 2; ++ai)
#pragma unroll
            for (int m = 0; m < 4; ++m) {
                f32x4 g0 = acc[ai][0][m][0] + bg0, g1 = acc[ai][0][m][1] + bg1, l0 = acc[ai][1][m][0] + bl0, l1 = acc[ai][1][m][1] + bl1;
                float o[8];
#pragma unroll
                for (int j = 0; j < 4; ++j) {
                    float g = fminf(g0[j], 7.0f), l = fminf(fmaxf(l0[j], -7.0f), 7.0f); o[j] = g * __builtin_amdgcn_rcpf(1.0f + __builtin_amdgcn_exp2f(-2.4554669595930156f * g)) * (l + 1.0f);
                    g = fminf(g1[j], 7.0f); l = fminf(fmaxf(l1[j], -7.0f), 7.0f); o[4 + j] = g * __builtin_amdgcn_rcpf(1.0f + __builtin_amdgcn_exp2f(-2.4554669595930156f * g)) * (l + 1.0f); }
                u32x4 w; w.x = cvt_pk_bf16(o[0], o[1]); w.y = cvt_pk_bf16(o[2], o[3]); w.z = cvt_pk_bf16(o[4], o[5]); w.w = cvt_pk_bf16(o[6], o[7]);
                *(u32x4*)(O + (size_t)(row0 + ai * HALF + m * 16) * 1024 + c0) = w; }
    }
};
struct EpiDown {
    static constexpr bool PERM = true, AFTER_DRAIN = false;
    bf16_t* Y; const float* bias;
    __device__ __forceinline__ void operator()(const f32x4 (&acc)[2][2][4][2], const Unit& u, int wr, int wc, int fr, int fq) const {
        const int row0 = u.pm * BM + wr * 64 + fr, col0 = u.pn * BM + wc * 32 + 8 * fq;
        const float* bb = bias + (size_t)u.e * 1024 + col0;
        f32x4 bv[2][2];
#pragma unroll
        for (int bj = 0; bj < 2; ++bj)
#pragma unroll
            for (int n = 0; n < 2; ++n) bv[bj][n] = *(const f32x4*)(bb + bj * HALF + 4 * n);
#pragma unroll
        for (int ai = 0; ai < 2; ++ai)
#pragma unroll
            for (int m = 0; m < 4; ++m) { bf16_t* rowp = Y + (size_t)(row0 + ai * HALF + m * 16) * 1024 + col0;
#pragma unroll
                for (int bj = 0; bj < 2; ++bj) { const f32x4 v0 = acc[ai][bj][m][0] + bv[bj][0], v1 = acc[ai][bj][m][1] + bv[bj][1];
                    u32x4 w; w.x = cvt_pk_bf16(v0[0], v0[1]); w.y = cvt_pk_bf16(v0[2], v0[3]); w.z = cvt_pk_bf16(v1[0], v1[1]); w.w = cvt_pk_bf16(v1[2], v1[3]);
                    *(u32x4*)(rowp + bj * HALF) = w; } }
    }
};

template <class Epi, class Sched, bool ALIGN_EPI = false, bool SP2 = false>
__device__ __forceinline__ void gemm_phase(PG8_LAS unsigned char* lds, const int K, const Sched& S, const Epi& E, const int wave_id) {
    int lane_; { unsigned m_ = ~0u; asm volatile("" : "+s"(m_)); lane_ = (int)__builtin_amdgcn_mbcnt_hi(m_, __builtin_amdgcn_mbcnt_lo(m_, 0u)); }
    int wid_ = wave_id; asm volatile("" : "+s"(wid_));
    const int wid = wid_, lane = lane_, tid = wid * 64 + lane, wr = wid >> 2, wc = wid & 3, fr = lane & 15, fq = lane >> 4;
    const int nt = K / BK;
    unsigned voffA[2], voffB[2];
#pragma unroll
    for (int i = 0; i < 2; ++i) { int R, C; stage_rc(tid * 16 + i * 8192, R, C); const int Rb = Epi::PERM ? ((R & ~31) + perm32(R & 31)) : R;
        voffA[i] = (unsigned)(R * K + C) * 2u; voffB[i] = (unsigned)(Rb * K + C) * 2u; }
    unsigned gRC[2];
#pragma unroll
    for (int i = 0; i < 2; ++i) { int R, C; stage_rc(tid * 16 + i * 8192, R, C); gRC[i] = (unsigned)R | ((unsigned)C * 2u << 8); }
    unsigned vcur[2][2];
#define PG8_GOFF(dst, ui_) do { if constexpr (Sched::GATHER) { _Pragma("unroll") for (int h_ = 0; h_ < 2; ++h_) _Pragma("unroll") for (int i_ = 0; i_ < 2; ++i_) dst[h_][i_] = S.arow((ui_), h_ * HALF + (int)(gRC[i_] & 255u)) * (unsigned)(K * 2) + (gRC[i_] >> 8); } } while (0)
#define PG8_STAGEA(bufoff, base, h, VO) do { if constexpr (Sched::GATHER) { PG8_STAGE(bufoff, base, VO[h]); } else { PG8_STAGE(bufoff, (base) + (h) * hstep, voffA); } } while (0)
    const size_t kstep = (size_t)(BK * 2);
    const size_t hstep = (size_t)HALF * K * 2;
    const unsigned ldsw = (unsigned)wid * 1024u;
    const int aoff = lds_byte(wr * 64 + fr, fq * 8), boff = lds_byte(wc * 32 + fr, fq * 8);
#define PG8_SA(b, h) (((b) * 2 + (h)) * HTB)
#define PG8_SB(b, h) ((4 + (b) * 2 + (h)) * HTB)
#define PG8_STAGE(bufoff, gbase, voff) do { _Pragma("unroll") for (int _i = 0; _i < 2; ++_i) \
        __builtin_amdgcn_global_load_lds((const unsigned*)((const char*)(gbase) + (voff)[_i]), (PG8_LAS unsigned*)(lds + (bufoff) + ldsw + _i * 8192), 16, 0, 0); } while (0)
#define PG8_LDA(dst, b, h) do { _Pragma("unroll") for (int m = 0; m < 4; ++m) _Pragma("unroll") for (int k = 0; k < 2; ++k) dst[m][k] = *(const PG8_LAS bf16x8*)(lds + PG8_SA(b, h) + aoff + m * 2048 + k * 1024); } while (0)
#define PG8_LDB(dst, b, h) do { _Pragma("unroll") for (int n = 0; n < 2; ++n) _Pragma("unroll") for (int k = 0; k < 2; ++k) dst[n][k] = *(const PG8_LAS bf16x8*)(lds + PG8_SB(b, h) + boff + n * 2048 + k * 1024); } while (0)
#define PG8_MMA(ai, bj, At, Bt) do { __builtin_amdgcn_s_setprio(1); _Pragma("unroll") for (int m = 0; m < 4; ++m) _Pragma("unroll") for (int n = 0; n < 2; ++n) _Pragma("unroll") for (int k = 0; k < 2; ++k) \
        acc[ai][bj][m][n] = __builtin_amdgcn_mfma_f32_16x16x32_bf16(Bt[n][k], At[m][k], acc[ai][bj][m][n], 0, 0, 0); __builtin_amdgcn_s_setprio(0); } while (0)
#define PG8_WAIT_V(n) asm volatile("s_waitcnt vmcnt(" #n ")" ::: "memory")
#define PG8_WAIT_L(n) asm volatile("s_waitcnt lgkmcnt(" #n ")" ::: "memory")
#define PG8_BAR __builtin_amdgcn_s_barrier()
#define PG8_SCHED __builtin_amdgcn_sched_barrier(0)
    Unit cur, nxt; int ui = 0;
    if (!S.next(0, cur)) return;
    f32x4 acc[2][2][4][2];
#pragma unroll
    for (int a = 0; a < 2; ++a)
#pragma unroll
        for (int b = 0; b < 2; ++b)
#pragma unroll
            for (int m = 0; m < 4; ++m)
#pragma unroll
                for (int n = 0; n < 2; ++n) acc[a][b][m][n] = (f32x4){0.f, 0.f, 0.f, 0.f};
    bf16x8 At[4][2], B0[2][2], B1[2][2];
    const char* cA = S.aptr(cur); const char* cB = S.bptr(cur);
    S.a_ready(cur);
    PG8_GOFF(vcur, 0);
    if constexpr (SP2) {
        PG8_STAGE(PG8_SB(0, 0), cB, voffB); PG8_STAGE(PG8_SB(0, 1), cB + hstep, voffB); PG8_STAGEA(PG8_SA(0, 0), cA, 0, vcur); PG8_STAGEA(PG8_SA(0, 1), cA, 1, vcur);
        if (wr == 1) PG8_BAR;
        PG8_WAIT_V(2); PG8_BAR;
        PG8_STAGE(PG8_SB(1, 0), cB + kstep, voffB); PG8_STAGEA(PG8_SA(1, 0), cA + kstep, 0, vcur); PG8_STAGE(PG8_SB(1, 1), cB + hstep + kstep, voffB);
        PG8_WAIT_V(6); PG8_BAR;
    } else {
        PG8_STAGE(PG8_SB(0, 0), cB, voffB); PG8_STAGEA(PG8_SA(0, 0), cA, 0, vcur); PG8_STAGE(PG8_SB(0, 1), cB + hstep, voffB); PG8_STAGEA(PG8_SA(0, 1), cA, 1, vcur);
        if (wr == 1) PG8_BAR;
        PG8_WAIT_V(4); PG8_BAR;
        PG8_STAGE(PG8_SB(1, 0), cB + kstep, voffB); PG8_STAGEA(PG8_SA(1, 0), cA + kstep, 0, vcur); PG8_STAGE(PG8_SB(1, 1), cB + hstep + kstep, voffB);
        PG8_WAIT_V(6); PG8_BAR;
    }
    for (;;) {
        const bool has_next = S.next(ui + 1, nxt);
        const char* nA = has_next ? S.aptr(nxt) : cA; const char* nB = has_next ? S.bptr(nxt) : cB;
        for (int t = 0; t < nt; t += 2) {
            const bool last = (t == nt - 2);
            const char* a1 = cA + (size_t)(t + 1) * kstep;
            const char* a2 = last ? nA : cA + (size_t)(t + 2) * kstep; const char* b2 = last ? nB : cB + (size_t)(t + 2) * kstep;
            const char* a3 = a2 + kstep; const char* b3 = b2 + kstep;
            if (last && has_next) S.a_ready(nxt);
            if constexpr (SP2) {
            PG8_LDB(B0, 0, 0); PG8_LDB(B1, 0, 1); PG8_SCHED; PG8_LDA(At, 0, 0); PG8_STAGEA(PG8_SA(1, 1), a1, 1, vcur);
            if constexpr (Sched::GATHER) { if (last && has_next) PG8_GOFF(vcur, ui + 1); }
            PG8_WAIT_V(8); PG8_WAIT_L(0); PG8_BAR; PG8_MMA(0, 0, At, B0); PG8_MMA(0, 1, At, B1); PG8_BAR; PG8_SCHED;
            PG8_LDA(At, 0, 1); PG8_STAGE(PG8_SB(0, 0), b2, voffB); PG8_STAGE(PG8_SB(0, 1), b2 + hstep, voffB); PG8_STAGEA(PG8_SA(0, 0), a2, 0, vcur);
            PG8_WAIT_V(8); PG8_WAIT_L(0); PG8_BAR; PG8_MMA(1, 0, At, B0); PG8_MMA(1, 1, At, B1); PG8_BAR; PG8_SCHED;
            PG8_LDB(B0, 1, 0); PG8_LDB(B1, 1, 1); PG8_SCHED; PG8_LDA(At, 1, 0); PG8_STAGEA(PG8_SA(0, 1), a2, 1, vcur);
            PG8_WAIT_V(8); PG8_WAIT_L(0); PG8_BAR; PG8_MMA(0, 0, At, B0); PG8_MMA(0, 1, At, B1); PG8_BAR; PG8_SCHED;
            PG8_LDA(At, 1, 1); PG8_STAGE(PG8_SB(1, 0), b3, voffB); PG8_STAGE(PG8_SB(1, 1), b3 + hstep, voffB); PG8_STAGEA(PG8_SA(1, 0), a3, 0, vcur);
            PG8_WAIT_V(8); PG8_WAIT_L(0); PG8_BAR; PG8_MMA(1, 0, At, B0); PG8_MMA(1, 1, At, B1); PG8_BAR; PG8_SCHED;
            } else {
            PG8_LDB(B0, 0, 0); PG8_SCHED; PG8_LDA(At, 0, 0); PG8_STAGEA(PG8_SA(1, 1), a1, 1, vcur);
            PG8_WAIT_L(8); PG8_BAR; PG8_WAIT_L(0); PG8_MMA(0, 0, At, B0); PG8_BAR; PG8_SCHED;
            PG8_LDB(B1, 0, 1); PG8_STAGE(PG8_SB(0, 0), b2, voffB);
            PG8_BAR; PG8_WAIT_L(0); PG8_MMA(0, 1, At, B1); PG8_BAR;
            PG8_LDA(At, 0, 1); PG8_STAGEA(PG8_SA(0, 0), a2, 0, vcur);
            PG8_BAR; PG8_WAIT_L(0); PG8_MMA(1, 0, At, B0); PG8_BAR; PG8_SCHED;
            PG8_STAGE(PG8_SB(0, 1), b2 + hstep, voffB);
            PG8_WAIT_V(6); PG8_BAR; PG8_MMA(1, 1, At, B1); PG8_BAR;
            PG8_LDB(B0, 1, 0); PG8_SCHED; PG8_LDA(At, 1, 0); PG8_STAGEA(PG8_SA(0, 1), a2, 1, vcur);
            PG8_WAIT_L(8); PG8_BAR; PG8_WAIT_L(0); PG8_MMA(0, 0, At, B0); PG8_BAR; PG8_SCHED;
            PG8_LDB(B1, 1, 1); PG8_STAGE(PG8_SB(1, 0), b3, voffB);
            PG8_BAR; PG8_WAIT_L(0); PG8_MMA(0, 1, At, B1); PG8_BAR;
            PG8_LDA(At, 1, 1); PG8_STAGEA(PG8_SA(1, 0), a3, 0, vcur);
            PG8_BAR; PG8_WAIT_L(0); PG8_MMA(1, 0, At, B0); PG8_BAR; PG8_SCHED;
            PG8_STAGE(PG8_SB(1, 1), b3 + hstep, voffB);
            PG8_WAIT_V(6); PG8_BAR; PG8_MMA(1, 1, At, B1); PG8_BAR;
            }
        }
        if constexpr (ALIGN_EPI) { if (wr == 0) PG8_BAR; }
        if constexpr (!Epi::AFTER_DRAIN) { E(acc, cur, wr, wc, fr, fq); S.done(cur); }
        if (!has_next) break;
#pragma unroll
        for (int a = 0; a < 2; ++a)
#pragma unroll
            for (int b = 0; b < 2; ++b)
#pragma unroll
                for (int m = 0; m < 4; ++m)
#pragma unroll
                    for (int n = 0; n < 2; ++n) acc[a][b][m][n] = (f32x4){0.f, 0.f, 0.f, 0.f};
        cur = nxt; cA = nA; cB = nB; ++ui;
        if constexpr (ALIGN_EPI) { if (wr == 1) PG8_BAR; }
    }
    PG8_WAIT_V(0);
    if constexpr (!ALIGN_EPI) { if (wr == 0) PG8_BAR; }
    PG8_BAR;
    if constexpr (Epi::AFTER_DRAIN) { E.fused(acc, cur, wr, wc, fr, fq, lds, wid, lane); S.done(cur); }
#undef PG8_GOFF
#undef PG8_STAGEA
#undef PG8_SA
#undef PG8_SB
#undef PG8_STAGE
#undef PG8_LDA
#undef PG8_LDB
#undef PG8_MMA
#undef PG8_WAIT_V
#undef PG8_WAIT_L
#undef PG8_BAR
#undef PG8_SCHED
}
}

#define LAS __attribute__((address_space(3)))
DI int lane_now() { unsigned m = ~0u; asm volatile("" : "+s"(m)); return (int)__builtin_amdgcn_mbcnt_hi(m, __builtin_amdgcn_mbcnt_lo(m, 0u)); }
#define XB_TMO      128
#define XB_XCNT(j)  (256  + 64 * (j))
#define XB_XSUB(j)  (1280 + 64 * (j))
#define XB_XGEN(j)  (2304 + 64 * (j))
#define XB_TOP      3328
#define XB_TOPGEN   3392
#define XCD_BAR_WORDS 3456
#define XB_SPIN_CAP (1u << 18)
__device__ __forceinline__ unsigned xb_ld(unsigned* p)              { return __hip_atomic_load(p, __ATOMIC_RELAXED, __HIP_MEMORY_SCOPE_AGENT); }
__device__ __forceinline__ unsigned xb_add(unsigned* p, unsigned v) { return __hip_atomic_fetch_add(p, v, __ATOMIC_RELAXED, __HIP_MEMORY_SCOPE_AGENT); }
__device__ __forceinline__ unsigned xb_xcc_id() { return (unsigned)__builtin_amdgcn_s_getreg((3 << 11) | 20) & 0xFu; }
#define XB_SPIN(cond, bar) do { unsigned _sp = 0; while (cond) { __builtin_amdgcn_s_sleep(1); \
    if ((++_sp & 255u) == 0u) { if (xb_ld(&(bar)[XB_TMO])) break; if (_sp > XB_SPIN_CAP) { atomicAdd(&(bar)[XB_TMO], 1u); break; } } } } while (0)
struct XcdBarrier { unsigned* bar; unsigned x; volatile LAS unsigned* st; int wave; };
__device__ __forceinline__ XcdBarrier xcd_barrier_post(unsigned* bar, volatile LAS unsigned* st) {
    XcdBarrier b; b.bar = bar; b.x = xb_xcc_id(); b.st = st;
    if (threadIdx.x == 0) (void)xb_add(&bar[XB_XCNT(b.x)], 1u);
    return b;
}
__device__ __forceinline__ void xcd_barrier_complete(unsigned* bar, unsigned x, unsigned& nloc, unsigned& nx) {
    const unsigned G = gridDim.x * gridDim.y * gridDim.z;
    unsigned sum, cnt, mine, sp = 0u;
    for (;;) {
        sum = 0u; cnt = 0u; mine = 0u;
#pragma unroll
        for (unsigned j = 0; j < 16; ++j) { const unsigned c = xb_ld(&bar[XB_XCNT(j)]); sum += c; cnt += (c > 0u) ? 1u : 0u; mine = (j == x) ? c : mine; }
        if (sum == G) break;
        __builtin_amdgcn_s_sleep(1);
        if ((++sp & 255u) == 0u) { if (xb_ld(&bar[XB_TMO])) break; if (sp > XB_SPIN_CAP) { atomicAdd(&bar[XB_TMO], 1u); break; } }
    }
    nloc = mine > 0u ? mine : 1u; nx = cnt > 0u ? cnt : 1u;
}
__device__ __forceinline__ void xcd_barrier(const XcdBarrier& b) {
    asm volatile("s_waitcnt vmcnt(0)" ::: "memory");
    __syncthreads();
    if (b.wave == 0 && lane_now() == 0) {
        unsigned* bar = b.bar;
        __builtin_amdgcn_s_waitcnt(0);
        unsigned nloc = b.st[0], nx = b.st[1];
        if (nloc == 0u) { xcd_barrier_complete(bar, b.x, nloc, nx); b.st[0] = nloc; b.st[1] = nx; }
        const unsigned old = xb_add(&bar[XB_XSUB(b.x)], 1u);
        const unsigned gen = old / nloc;
        if (old + 1u == (gen + 1u) * nloc) {
            __builtin_amdgcn_fence(__ATOMIC_RELEASE, "agent");
            asm volatile("s_waitcnt vmcnt(0)" ::: "memory");
            const unsigned og = xb_add(&bar[XB_TOP], 1u);
            const unsigned tg = og / nx;
            if (og + 1u == (tg + 1u) * nx) xb_add(&bar[XB_TOPGEN], 1u);
            else XB_SPIN(xb_ld(&bar[XB_TOPGEN]) == tg, bar);
            __builtin_amdgcn_fence(__ATOMIC_ACQUIRE, "agent");
            xb_add(&bar[XB_XGEN(b.x)], 1u);
            asm volatile("s_waitcnt vmcnt(0)" ::: "memory");
        } else {
            XB_SPIN(xb_ld(&bar[XB_XGEN(b.x)]) == gen, bar);
            __builtin_amdgcn_fence(__ATOMIC_ACQUIRE, "agent");
            asm volatile("s_waitcnt vmcnt(0)" ::: "memory");
        }
    }
    __syncthreads();
}

struct Args { const float* in[37]; float* out; unsigned char* ws; int ph_lo, ph_hi; int probe, pad; };
struct Frame {
    unsigned char* lds;
    unsigned char* ws;
    int tid, lane, wave, G, bid;
};
enum { I_X = 0, I_MEM, I_REL, I_NSA_WIN, I_NSA_GB, I_NSA_PE, I_NSA_W1, I_NSA_W2, I_GLA_WIN, I_GLA_WA2, I_GLA_BA, I_GLA_BOG, I_GLA_NW,
       I_RW_WIN, I_RW_MU, I_RW_W0, I_RW_W2, I_RW_A0, I_RW_A2, I_RW_G2, I_RW_KK, I_RW_KA, I_RW_RK, I_RW_LNW, I_RW_LNB,
       I_MEM_WKV, I_WOUT, I_LN1G, I_LN1B, I_LN2G, I_LN2B, I_RTW, I_RTB, I_WGU, I_BGU, I_WDN, I_BDN };

DI void enter(Frame& F) { int l = lane_now();
    F.lane = l; F.tid = F.wave * 64 + l;
    { int b_ = F.bid, g_ = F.G, w_ = F.wave; asm volatile("" : "+s"(b_), "+s"(g_), "+s"(w_)); F.bid = b_; F.G = g_; F.wave = w_; F.tid = w_ * 64 + l; }
    unsigned long long w = (unsigned long long)F.ws; asm volatile("" : "+s"(w));
    F.ws = (unsigned char*)(__attribute__((address_space(1))) unsigned char*)w; }
DI void transpose_item(const float* W, int K, int N, int nblk, bf16* WT, int mode, unsigned short* scr, int item, int lane) {
    const int grp = item >> 3, w8 = item & 7, ngn = nblk >> 1, kb = 4 * (grp / ngn) + (w8 >> 1), nb = 2 * (grp % ngn) + (w8 & 1), k0 = 64 * kb, n0 = 64 * nb;
    const int nn = n0 + 4 * (lane & 15);
    f32x4 v[16];
#pragma unroll
    for (int i = 0; i < 16; ++i) { const int kk = 4 * i + (lane >> 4); const float* src = W + (size_t)(k0 + kk) * N + nn;
        if (nn + 3 < N) v[i] = __builtin_nontemporal_load((const f32x4*)src);
        else { v[i][0] = nn < N ? src[0] : 0.f; v[i][1] = nn + 1 < N ? src[1] : 0.f; v[i][2] = nn + 2 < N ? src[2] : 0.f; v[i][3] = 0.f; } }
#pragma unroll
    for (int i = 0; i < 16; ++i) { const int kk = 4 * i + (lane >> 4); v2u o; o.x = pk2(v[i][0], v[i][1]); o.y = pk2(v[i][2], v[i][3]); *(v2u*)(scr + kk * 68 + 4 * (lane & 15)) = o; }
    asm volatile("s_waitcnt lgkmcnt(0)" ::: "memory");
    int d0 = n0;
    if (mode == 1) d0 = (n0 < 1024) ? 256 * (n0 >> 7) + (n0 & 127) : 256 * ((n0 - 1024) >> 7) + 128 + ((n0 - 1024) & 127);
    const int c = lane & 7;
#pragma unroll
    for (int j = 0; j < 8; ++j) { const int n = (lane >> 3) + 8 * j; const unsigned short* s = scr + (8 * c) * 68 + n;
        v4u o; o.x = (unsigned)s[0] | ((unsigned)s[68] << 16); o.y = (unsigned)s[2 * 68] | ((unsigned)s[3 * 68] << 16); o.z = (unsigned)s[4 * 68] | ((unsigned)s[5 * 68] << 16); o.w = (unsigned)s[6 * 68] | ((unsigned)s[7 * 68] << 16);
        *(v4u*)(WT + (size_t)(d0 + n) * K + k0 + 8 * c) = o; }
    asm volatile("s_waitcnt lgkmcnt(0)" ::: "memory");
}
DI void phase_prologue(const Args& a, Frame& F) {
    enter(F);
    unsigned short* scr = (unsigned short*)(F.lds + F.wave * 8704);
    const int gw = F.bid * 8 + F.wave, NGW = F.G * 8;
    constexpr int I_IN = 16 * 44, I_OUT = 16 * 16, I_KV = 16 * 8, I_C1 = 32 * 4, I_GU = 16 * 32, I_DN = 16 * 16;
    constexpr int N0 = 4 * I_IN, N1 = N0 + 4 * I_OUT, N2 = N1 + 4 * I_KV, N3 = N2 + 4 * I_C1, N4 = N3 + 128 * I_GU, N5 = N4 + 128 * I_DN;
    for (int it = gw; it < N5; it += NGW) {
        if (it < N0) { const int L = it / I_IN, r = it % I_IN, kind = L % 3, j = L / 3;
            const int cols = kind == 0 ? NSA_COLS : kind == 1 ? GLA_COLS : RWKV_COLS;
            const float* W = (kind == 0 ? a.in[I_NSA_WIN] : kind == 1 ? a.in[I_GLA_WIN] : a.in[I_RW_WIN]) + (size_t)j * D * cols;
            transpose_item(W, D, cols, 44, (bf16*)(F.ws + WS_WIN + (size_t)L * WIN_STRIDE), 0, scr, r, F.lane); }
        else if (it < N1) { const int q = it - N0, L = q / I_OUT, r = q % I_OUT;
            transpose_item(a.in[I_WOUT] + (size_t)L * D * D, D, D, 16, (bf16*)(F.ws + WS_WOUT) + (size_t)L * D * D, 0, scr, r, F.lane); }
        else if (it < N2) { const int q = it - N1, L = q / I_KV, r = q % I_KV;
            transpose_item(a.in[I_MEM_WKV] + (size_t)L * D * 512, D, 512, 8, (bf16*)(F.ws + WS_WKV) + (size_t)L * 512 * D, 0, scr, r, F.lane); }
        else if (it < N3) { const int q = it - N2, L = q / I_C1, r = q % I_C1;
            transpose_item(a.in[I_NSA_W1] + (size_t)L * 2048 * 256, 2048, 256, 4, (bf16*)(F.ws + WS_CW1) + (size_t)L * 256 * 2048, 0, scr, r, F.lane); }
        else if (it < N4) { const int q = it - N3, L = q / I_GU, r = q % I_GU;
            transpose_item(a.in[I_WGU] + (size_t)L * D * 2048, D, 2048, 32, (bf16*)(F.ws + WS_WGU) + (size_t)L * 2048 * D, 1, scr, r, F.lane); }
        else { const int q = it - N4, L = q / I_DN, r = q % I_DN;
            transpose_item(a.in[I_WDN] + (size_t)L * D * D, D, D, 16, (bf16*)(F.ws + WS_WDN) + (size_t)L * D * D, 0, scr, r, F.lane); }
    }
    { bf16* WL = (bf16*)(F.ws + 42 * MiB); const float* w2 = a.in[I_RW_W2], *a2 = a.in[I_RW_A2], *g2 = a.in[I_RW_G2];
      for (int blk = F.bid; blk < 2304 * 256 / 512; blk += F.G) { const int i = blk * 512 + F.tid; const int k = i & 255, n = i >> 8; float v = 0.f;
          if (n < 768) { if (k < 64) v = w2[k * 768 + n]; } else if (n < 1536) { if (k >= 64 && k < 128) v = a2[(k - 64) * 768 + (n - 768)]; } else { if (k >= 128) v = g2[(k - 128) * 768 + (n - 1536)]; }
          WL[i] = (bf16)f2bf(v); } }
    { bf16* W2T = (bf16*)(F.ws + WS_CW2T); const float* w2 = a.in[I_NSA_W2];
      for (int blk = F.bid; blk < 4 * 64 * 256 / 512; blk += F.G) { const int i = blk * 512 + F.tid; const int k = i & 255, dd = (i >> 8) & 63, m = i >> 14; W2T[i] = (bf16)f2bf(w2[((size_t)m * 256 + k) * 64 + dd]); } }
    const f32x4* x4 = (const f32x4*)a.in[I_X]; v2u* xb = (v2u*)(F.ws + WS_XB);
    for (int blk = F.bid; blk < T * D / 4 / 512 / 8; blk += F.G) {
        f32x4 v[8];
#pragma unroll
        for (int q = 0; q < 8; ++q) v[q] = __builtin_nontemporal_load(x4 + ((size_t)blk * 8 + q) * 512 + F.tid);
#pragma unroll
        for (int q = 0; q < 8; ++q) { v2u o; o.x = pk2(v[q][0], v[q][1]); o.y = pk2(v[q][2], v[q][3]); xb[((size_t)blk * 8 + q) * 512 + F.tid] = o; } }
    const f32x4* m4 = (const f32x4*)a.in[I_MEM]; v2u* mb = (v2u*)(F.ws + WS_MEMB);
    for (int blk = F.bid; blk < BATCH * MEMLEN * D / 4 / 512; blk += F.G) { const size_t i = (size_t)blk * 512 + F.tid; const f32x4 v = m4[i]; v2u o; o.x = pk2(v[0], v[1]); o.y = pk2(v[2], v[3]); mb[i] = o; }
}


typedef short bf16x8 __attribute__((ext_vector_type(8)));
typedef short s16x4 __attribute__((ext_vector_type(4)));
typedef float f32x16 __attribute__((ext_vector_type(16)));
typedef __bf16 bf16x2_t __attribute__((ext_vector_type(2)));
typedef short v4i16_t __attribute__((ext_vector_type(4)));
constexpr float LOG2E = 1.4426950408889634f;
constexpr int KVP = 144;
constexpr int KVTILE = 64 * KVP;
DI int crow(int r, int hi) { return (r & 3) + 8 * (r >> 2) + 4 * hi; }
DI unsigned cvtpk(float lo, float hi) { f32x2 v = {lo, hi}; bf16x2_t b = __builtin_convertvector(v, bf16x2_t); return __builtin_bit_cast(unsigned, b); }
DI s16x4 vtr(const unsigned char* p) { return __builtin_bit_cast(s16x4, __builtin_amdgcn_ds_read_tr16_b64_v4i16((LAS v4i16_t*)(LAS unsigned char*)p)); }
DI float xhalf(float v) { return __shfl_xor(v, 32); }
DI float xmax_half(float v) { const unsigned b = __builtin_bit_cast(unsigned, v); const auto r = __builtin_amdgcn_permlane32_swap(b, b, false, false);
    return fmaxf(__builtin_bit_cast(float, (unsigned)r[0]), __builtin_bit_cast(float, (unsigned)r[1])); }
DI float xsum_half(float v) { const unsigned b = __builtin_bit_cast(unsigned, v); const auto r = __builtin_amdgcn_permlane32_swap(b, b, false, false);
    return __builtin_bit_cast(float, (unsigned)r[0]) + __builtin_bit_cast(float, (unsigned)r[1]); }

DI bf16x8 frag_row(const unsigned char* base, int pitch, int row, int col) { return *(const bf16x8*)(base + row * pitch + col * 2); }
DI bf16x8 frag_col8(const unsigned char* base, int pitch, int r0, int c0, int lane) {
    const unsigned char* p = base + (r0 + ((lane & 15) >> 2)) * pitch + (c0 + ((lane >> 4) & 1) * 16 + (lane & 3) * 4) * 2;
    const s16x4 a = vtr(p), b = vtr(p + 4 * pitch);
    return (bf16x8){a[0], a[1], a[2], a[3], b[0], b[1], b[2], b[3]};
}
DI bf16x8 frag_col44(const unsigned char* base, int pitch, int r0, int c0, int lane) {
    const unsigned char* p = base + (r0 + ((lane & 15) >> 2)) * pitch + (c0 + ((lane >> 4) & 1) * 16 + (lane & 3) * 4) * 2;
    const s16x4 a = vtr(p), b = vtr(p + 8 * pitch);
    return (bf16x8){a[0], a[1], a[2], a[3], b[0], b[1], b[2], b[3]};
}
DI bf16x8 pack_acc(const f32x16& x, int s) {
    v4u w; w.x = cvtpk(x[8 * s], x[8 * s + 1]); w.y = cvtpk(x[8 * s + 2], x[8 * s + 3]); w.z = cvtpk(x[8 * s + 4], x[8 * s + 5]); w.w = cvtpk(x[8 * s + 6], x[8 * s + 7]);
    return __builtin_bit_cast(bf16x8, w);
}
#define MFMA32(a, b, c) __builtin_amdgcn_mfma_f32_32x32x16_bf16((a), (b), (c), 0, 0, 0)

struct AttnAcc { f32x16 o0, o1; float m, l; };
DI void attn_init(AttnAcc& A) {
#pragma unroll
    for (int i = 0; i < 16; ++i) { A.o0[i] = 0.f; A.o1[i] = 0.f; }
    A.m = -1e30f; A.l = 0.f;
}
struct KVRegs { v4u k, v; };
DI void kv_load(KVRegs& R, const bf16* Kg, const bf16* Vg, size_t ld, int tid) {
    const int row = tid >> 3, ch = tid & 7;
    R.k = *(const v4u*)(Kg + (size_t)row * ld + ch * 8); R.v = *(const v4u*)(Vg + (size_t)row * ld + ch * 8);
}
DI void kv_store(const KVRegs& R, unsigned char* Kl, unsigned char* Vl, int tid) {
    const int row = tid >> 3, ch = tid & 7;
    *(v4u*)(Kl + row * KVP + ch * 16) = R.k; *(v4u*)(Vl + row * KVP + ch * 16) = R.v;
}
constexpr int SWTILE = 8192;
template <bool SWZ> DI const unsigned char* kfrag_addr(const unsigned char* base, int row, int dc, int hi) {
    return SWZ ? base + row * 128 + (((2 * dc + hi) ^ (row & 7)) << 4) : base + row * KVP + dc * 32 + hi * 16;
}
template <bool SWZ> DI const unsigned char* vtr_addr(const unsigned char* base, int ks, int d0, int lane) {
    const int hi = lane >> 5, q = (lane & 15) >> 2, rowq = 4 * hi + q, row = 16 * ks + rowq;
    if (SWZ) { const int chunk = 4 * d0 + 2 * ((lane >> 4) & 1) + ((lane & 3) >> 1); return base + row * 128 + ((chunk ^ rowq) << 4) + (lane & 1) * 8; }
    return base + row * KVP + (d0 * 32 + ((lane >> 4) & 1) * 16 + (lane & 3) * 4) * 2;
}
DI void kv_dma(const bf16* Kg, const bf16* Vg, size_t ld, unsigned char* Kl, unsigned char* Vl, int wave, int lane) {
    const int row = 8 * wave + (lane >> 3), ch = (lane & 7) ^ (lane >> 3);
    __builtin_amdgcn_global_load_lds((const unsigned*)(Kg + (size_t)row * ld + ch * 8), (LAS unsigned*)(LAS unsigned char*)(Kl + wave * 1024), 16, 0, 0);
    __builtin_amdgcn_global_load_lds((const unsigned*)(Vg + (size_t)row * ld + ch * 8), (LAS unsigned*)(LAS unsigned char*)(Vl + wave * 1024), 16, 0, 0);
}
DI void vtr16_asm(s16x4 (&o)[16], unsigned a0, unsigned a1) {
    asm volatile(
        "ds_read_b64_tr_b16 %0, %16\n\tds_read_b64_tr_b16 %1, %16 offset:1024\n\tds_read_b64_tr_b16 %2, %17\n\tds_read_b64_tr_b16 %3, %17 offset:1024\n\t"
        "ds_read_b64_tr_b16 %4, %16 offset:2048\n\tds_read_b64_tr_b16 %5, %16 offset:3072\n\tds_read_b64_tr_b16 %6, %17 offset:2048\n\tds_read_b64_tr_b16 %7, %17 offset:3072\n\t"
        "ds_read_b64_tr_b16 %8, %16 offset:4096\n\tds_read_b64_tr_b16 %9, %16 offset:5120\n\tds_read_b64_tr_b16 %10, %17 offset:4096\n\tds_read_b64_tr_b16 %11, %17 offset:5120\n\t"
        "ds_read_b64_tr_b16 %12, %16 offset:6144\n\tds_read_b64_tr_b16 %13, %16 offset:7168\n\tds_read_b64_tr_b16 %14, %17 offset:6144\n\tds_read_b64_tr_b16 %15, %17 offset:7168\n\t"
        "s_waitcnt lgkmcnt(0)"
        : "=&v"(o[0]), "=&v"(o[1]), "=&v"(o[2]), "=&v"(o[3]), "=&v"(o[4]), "=&v"(o[5]), "=&v"(o[6]), "=&v"(o[7]),
          "=&v"(o[8]), "=&v"(o[9]), "=&v"(o[10]), "=&v"(o[11]), "=&v"(o[12]), "=&v"(o[13]), "=&v"(o[14]), "=&v"(o[15])
        : "v"(a0), "v"(a1) : "memory");
}
DI unsigned lds_addr(const unsigned char* p) { return (unsigned)(uintptr_t)p; }
template <bool GENERAL, bool NOBIAS, bool SWZ = false>
DI void attn_tile(const unsigned char* Kl, const unsigned char* Vl, const bf16x8 (&qf)[4], AttnAcc& A, int lane, bool en, int dq, int lim, const float* btab, float cfar) {
    const int r32 = lane & 31, hi = lane >> 5;
    f32x16 p0, p1;
#pragma unroll
    for (int i = 0; i < 16; ++i) { p0[i] = 0.f; p1[i] = 0.f; }
#pragma unroll
    for (int dc = 0; dc < 4; ++dc) {
        const bf16x8 k0 = *(const bf16x8*)kfrag_addr<SWZ>(Kl, r32, dc, hi), k1 = *(const bf16x8*)kfrag_addr<SWZ>(Kl, r32 + 32, dc, hi);
        p0 = __builtin_amdgcn_mfma_f32_32x32x16_bf16(k0, qf[dc], p0, 0, 0, 0);
        p1 = __builtin_amdgcn_mfma_f32_32x32x16_bf16(k1, qf[dc], p1, 0, 0, 0);
    }
    const float NEG = -1e30f;
    float mx;
    float cl = 0.f;
    if (GENERAL) {
        const float ce = en ? 0.f : NEG;
        int dqh = dq - 4 * hi; asm volatile("" : "+v"(dqh));
        if (lim == 1) {
            const float* rb = btab + (191 - dqh);
#pragma unroll
            for (int r = 0; r < 16; ++r) { const int o = (r & 3) + 8 * (r >> 2); p0[r] = p0[r] * LOG2E + (rb[o] + ce); p1[r] = p1[r] * LOG2E + (rb[32 + o] + ce); }
        } else if (lim == 2) {
            const float* rb = btab + (191 - dqh);
#pragma unroll
            for (int r = 0; r < 16; ++r) { const int o = (r & 3) + 8 * (r >> 2);
                p0[r] = (o <= dqh) ? p0[r] * LOG2E + (rb[o] + ce) : NEG; p1[r] = (o + 32 <= dqh) ? p1[r] * LOG2E + (rb[32 + o] + ce) : NEG; }
        } else {
            const int kmin = dqh - 512; const float cb = cfar + ce;
#pragma unroll
            for (int r = 0; r < 16; ++r) { const int o = (r & 3) + 8 * (r >> 2);
                p0[r] = (o > kmin) ? p0[r] * LOG2E + cb : NEG; p1[r] = (o + 32 > kmin) ? p1[r] * LOG2E + cb : NEG; }
        }
        mx = fmaxf(p0[0], p1[0]);
#pragma unroll
        for (int r = 1; r < 16; ++r) mx = fmaxf(fmaxf(mx, p0[r]), p1[r]);
    } else {
        float pm = fmaxf(p0[0], p1[0]);
#pragma unroll
        for (int r = 1; r < 16; ++r) pm = fmaxf(fmaxf(pm, p0[r]), p1[r]);
        cl = NOBIAS ? 0.f : (en ? cfar : NEG);
        mx = pm * LOG2E + cl;
    }
    mx = xmax_half(mx);
    const float mn = fmaxf(A.m, mx);
    if (__any(mn > A.m)) {
        const float alpha = __builtin_amdgcn_exp2f(A.m - mn);
        A.l *= alpha;
#pragma unroll
        for (int r = 0; r < 16; ++r) { A.o0[r] *= alpha; A.o1[r] *= alpha; }
        A.m = mn;
    }
    float rs = 0.f;
    if (GENERAL) {
#pragma unroll
        for (int r = 0; r < 16; ++r) { p0[r] = __builtin_amdgcn_exp2f(p0[r] - mn); p1[r] = __builtin_amdgcn_exp2f(p1[r] - mn); rs += p0[r] + p1[r]; }
    } else {
        const float c2 = cl - mn;
#pragma unroll
        for (int r = 0; r < 16; ++r) { p0[r] = __builtin_amdgcn_exp2f(p0[r] * LOG2E + c2); p1[r] = __builtin_amdgcn_exp2f(p1[r] * LOG2E + c2); rs += p0[r] + p1[r]; }
    }
    A.l += rs;
    bf16x8 pa[4];
#pragma unroll
    for (int s = 0; s < 2; ++s) {
        v4u w0, w1;
        w0.x = cvtpk(p0[8 * s], p0[8 * s + 1]); w0.y = cvtpk(p0[8 * s + 2], p0[8 * s + 3]); w0.z = cvtpk(p0[8 * s + 4], p0[8 * s + 5]); w0.w = cvtpk(p0[8 * s + 6], p0[8 * s + 7]);
        w1.x = cvtpk(p1[8 * s], p1[8 * s + 1]); w1.y = cvtpk(p1[8 * s + 2], p1[8 * s + 3]); w1.z = cvtpk(p1[8 * s + 4], p1[8 * s + 5]); w1.w = cvtpk(p1[8 * s + 6], p1[8 * s + 7]);
        pa[s] = __builtin_bit_cast(bf16x8, w0); pa[2 + s] = __builtin_bit_cast(bf16x8, w1);
    }
    if constexpr (SWZ) {
        s16x4 vv[16]; vtr16_asm(vv, lds_addr(vtr_addr<true>(Vl, 0, 0, lane)), lds_addr(vtr_addr<true>(Vl, 0, 1, lane)));
#pragma unroll
        for (int ks = 0; ks < 4; ++ks) {
            const bf16x8 v0 = {vv[4 * ks][0], vv[4 * ks][1], vv[4 * ks][2], vv[4 * ks][3], vv[4 * ks + 1][0], vv[4 * ks + 1][1], vv[4 * ks + 1][2], vv[4 * ks + 1][3]};
            const bf16x8 v1 = {vv[4 * ks + 2][0], vv[4 * ks + 2][1], vv[4 * ks + 2][2], vv[4 * ks + 2][3], vv[4 * ks + 3][0], vv[4 * ks + 3][1], vv[4 * ks + 3][2], vv[4 * ks + 3][3]};
            A.o0 = __builtin_amdgcn_mfma_f32_32x32x16_bf16(v0, pa[ks], A.o0, 0, 0, 0);
            A.o1 = __builtin_amdgcn_mfma_f32_32x32x16_bf16(v1, pa[ks], A.o1, 0, 0, 0);
        }
    } else {
#pragma unroll
        for (int ks = 0; ks < 4; ++ks) {
            const unsigned char* v0p = vtr_addr<false>(Vl, ks, 0, lane); const unsigned char* v1p = vtr_addr<false>(Vl, ks, 1, lane); constexpr int R8 = 8 * KVP;
            const s16x4 a0l = vtr(v0p), a0h = vtr(v0p + R8), a1l = vtr(v1p), a1h = vtr(v1p + R8);
            const bf16x8 v0 = {a0l[0], a0l[1], a0l[2], a0l[3], a0h[0], a0h[1], a0h[2], a0h[3]};
            const bf16x8 v1 = {a1l[0], a1l[1], a1l[2], a1l[3], a1h[0], a1h[1], a1h[2], a1h[3]};
            A.o0 = __builtin_amdgcn_mfma_f32_32x32x16_bf16(v0, pa[ks], A.o0, 0, 0, 0);
            A.o1 = __builtin_amdgcn_mfma_f32_32x32x16_bf16(v1, pa[ks], A.o1, 0, 0, 0);
        }
    }
}
template <bool SWZ = false>
DI void attn_tile2(const unsigned char* Ka, const unsigned char* Va, const unsigned char* Kb, const unsigned char* Vb, const bf16x8 (&qf)[4], AttnAcc& A, int lane, float ca, float cb) {
    const int r32 = lane & 31, hi = lane >> 5;
    f32x16 p0, p1, p2, p3;
#pragma unroll
    for (int i = 0; i < 16; ++i) { p0[i] = 0.f; p1[i] = 0.f; p2[i] = 0.f; p3[i] = 0.f; }
    if constexpr (SWZ) __builtin_amdgcn_s_setprio(1);
#pragma unroll
    for (int dc = 0; dc < 4; ++dc) {
        p0 = MFMA32(*(const bf16x8*)kfrag_addr<SWZ>(Ka, r32, dc, hi), qf[dc], p0); p1 = MFMA32(*(const bf16x8*)kfrag_addr<SWZ>(Ka, r32 + 32, dc, hi), qf[dc], p1);
        p2 = MFMA32(*(const bf16x8*)kfrag_addr<SWZ>(Kb, r32, dc, hi), qf[dc], p2); p3 = MFMA32(*(const bf16x8*)kfrag_addr<SWZ>(Kb, r32 + 32, dc, hi), qf[dc], p3);
    }
    if constexpr (SWZ) __builtin_amdgcn_s_setprio(0);
    float ma = fmaxf(p0[0], p1[0]), mb = fmaxf(p2[0], p3[0]);
#pragma unroll
    for (int r = 1; r < 16; ++r) { ma = fmaxf(fmaxf(ma, p0[r]), p1[r]); mb = fmaxf(fmaxf(mb, p2[r]), p3[r]); }
    float mx = fmaxf(ma * LOG2E + ca, mb * LOG2E + cb);
    mx = xmax_half(mx);
    const float mn = fmaxf(A.m, mx);
    if (__any(mn > A.m)) {
        const float alpha = __builtin_amdgcn_exp2f(A.m - mn);
        A.l *= alpha;
#pragma unroll
        for (int r = 0; r < 16; ++r) { A.o0[r] *= alpha; A.o1[r] *= alpha; }
        A.m = mn;
    }
    const float c2a = ca - mn, c2b = cb - mn; float rs = 0.f;
#pragma unroll
    for (int r = 0; r < 16; ++r) { p0[r] = __builtin_amdgcn_exp2f(p0[r] * LOG2E + c2a); p1[r] = __builtin_amdgcn_exp2f(p1[r] * LOG2E + c2a);
        p2[r] = __builtin_amdgcn_exp2f(p2[r] * LOG2E + c2b); p3[r] = __builtin_amdgcn_exp2f(p3[r] * LOG2E + c2b); rs += (p0[r] + p1[r]) + (p2[r] + p3[r]); }
    A.l += rs;
    if constexpr (SWZ) {
        s16x4 vv[16];
        __builtin_amdgcn_s_setprio(1);
        vtr16_asm(vv, lds_addr(vtr_addr<true>(Va, 0, 0, lane)), lds_addr(vtr_addr<true>(Va, 0, 1, lane)));
#pragma unroll
        for (int ks = 0; ks < 4; ++ks) { const bf16x8 pa = pack_acc(ks < 2 ? p0 : p1, ks & 1);
            A.o0 = MFMA32(((bf16x8){vv[4 * ks][0], vv[4 * ks][1], vv[4 * ks][2], vv[4 * ks][3], vv[4 * ks + 1][0], vv[4 * ks + 1][1], vv[4 * ks + 1][2], vv[4 * ks + 1][3]}), pa, A.o0);
            A.o1 = MFMA32(((bf16x8){vv[4 * ks + 2][0], vv[4 * ks + 2][1], vv[4 * ks + 2][2], vv[4 * ks + 2][3], vv[4 * ks + 3][0], vv[4 * ks + 3][1], vv[4 * ks + 3][2], vv[4 * ks + 3][3]}), pa, A.o1); }
        vtr16_asm(vv, lds_addr(vtr_addr<true>(Vb, 0, 0, lane)), lds_addr(vtr_addr<true>(Vb, 0, 1, lane)));
#pragma unroll
        for (int ks = 0; ks < 4; ++ks) { const bf16x8 pb = pack_acc(ks < 2 ? p2 : p3, ks & 1);
            A.o0 = MFMA32(((bf16x8){vv[4 * ks][0], vv[4 * ks][1], vv[4 * ks][2], vv[4 * ks][3], vv[4 * ks + 1][0], vv[4 * ks + 1][1], vv[4 * ks + 1][2], vv[4 * ks + 1][3]}), pb, A.o0);
            A.o1 = MFMA32(((bf16x8){vv[4 * ks + 2][0], vv[4 * ks + 2][1], vv[4 * ks + 2][2], vv[4 * ks + 2][3], vv[4 * ks + 3][0], vv[4 * ks + 3][1], vv[4 * ks + 3][2], vv[4 * ks + 3][3]}), pb, A.o1); }
        __builtin_amdgcn_s_setprio(0);
    } else {
#pragma unroll
        for (int ks = 0; ks < 4; ++ks) {
            const bf16x8 pa = pack_acc(ks < 2 ? p0 : p1, ks & 1), pb = pack_acc(ks < 2 ? p2 : p3, ks & 1);
            constexpr int R8 = 8 * KVP;
            const unsigned char* va0 = vtr_addr<false>(Va, ks, 0, lane); const unsigned char* va1 = vtr_addr<false>(Va, ks, 1, lane);
            const unsigned char* vb0 = vtr_addr<false>(Vb, ks, 0, lane); const unsigned char* vb1 = vtr_addr<false>(Vb, ks, 1, lane);
            const s16x4 a0l = vtr(va0), a0h = vtr(va0 + R8), a1l = vtr(va1), a1h = vtr(va1 + R8);
            const s16x4 b0l = vtr(vb0), b0h = vtr(vb0 + R8), b1l = vtr(vb1), b1h = vtr(vb1 + R8);
            A.o0 = MFMA32(((bf16x8){a0l[0], a0l[1], a0l[2], a0l[3], a0h[0], a0h[1], a0h[2], a0h[3]}), pa, A.o0);
            A.o1 = MFMA32(((bf16x8){a1l[0], a1l[1], a1l[2], a1l[3], a1h[0], a1h[1], a1h[2], a1h[3]}), pa, A.o1);
            A.o0 = MFMA32(((bf16x8){b0l[0], b0l[1], b0l[2], b0l[3], b0h[0], b0h[1], b0h[2], b0h[3]}), pb, A.o0);
            A.o1 = MFMA32(((bf16x8){b1l[0], b1l[1], b1l[2], b1l[3], b1h[0], b1h[1], b1h[2], b1h[3]}), pb, A.o1);
        }
    }
}
DI void attn_finish(AttnAcc& A) {
    const float lt = xsum_half(A.l); const float inv = 1.0f / fmaxf(lt, 1e-30f);
#pragma unroll
    for (int r = 0; r < 16; ++r) { A.o0[r] *= inv; A.o1[r] *= inv; }
}
DI void load_q(bf16x8 (&qf)[4], const bf16* qrow, int hi) {
#pragma unroll
    for (int dc = 0; dc < 4; ++dc) { const v4u raw = *(const v4u*)(qrow + dc * 16 + hi * 8); v4u o;
        o.x = cvtpk(bf2f((unsigned short)(raw.x & 0xffff)) * 0.125f, bf2f((unsigned short)(raw.x >> 16)) * 0.125f);
        o.y = cvtpk(bf2f((unsigned short)(raw.y & 0xffff)) * 0.125f, bf2f((unsigned short)(raw.y >> 16)) * 0.125f);
        o.z = cvtpk(bf2f((unsigned short)(raw.z & 0xffff)) * 0.125f, bf2f((unsigned short)(raw.z >> 16)) * 0.125f);
        o.w = cvtpk(bf2f((unsigned short)(raw.w & 0xffff)) * 0.125f, bf2f((unsigned short)(raw.w >> 16)) * 0.125f);
        qf[dc] = __builtin_bit_cast(bf16x8, o); }
}

DI void phase_memattn_mfma(Frame& F, int qoff, int b0) {
    enter(F);
    const bf16* HB = (const bf16*)(F.ws + WS_HB); const bf16* KVB = (const bf16*)(F.ws + WS_KVB); bf16* CAT = (bf16*)(F.ws + WS_CAT);
    unsigned char* Kl = F.lds; unsigned char* Vl = F.lds + 4 * KVTILE;
    const int lane = F.lane, r32 = lane & 31, hi = lane >> 5;
    if (F.bid < b0) return;
    for (int u = F.bid - b0; u < BATCH * 4 * 16; u += F.G - b0) {
        const int b = u >> 6, head = (u >> 4) & 3, qt = u & 15;
        lds_barrier();
#pragma unroll
        for (int kt = 0; kt < 4; ++kt) { KVRegs R; const bf16* kg = KVB + (size_t)(b * 256 + kt * 64) * 512 + head * 64; kv_load(R, kg, kg + 256, 512, F.tid); kv_store(R, Kl + kt * KVTILE, Vl + kt * KVTILE, F.tid); }
        lds_barrier();
        const int t = b * SEQ + qt * 256 + F.wave * 32 + r32;
        bf16x8 qf[4]; load_q(qf, HB + (size_t)t * HC + qoff + head * 64, hi);
        AttnAcc A; attn_init(A);
#pragma unroll 1
        for (int kt = 0; kt < 4; kt += 2) attn_tile2(Kl + kt * KVTILE, Vl + kt * KVTILE, Kl + (kt + 1) * KVTILE, Vl + (kt + 1) * KVTILE, qf, A, lane, 0.f, 0.f);
        attn_finish(A);
        bf16* op = CAT + (size_t)t * D + TOKW + head * 64;
#pragma unroll
        for (int rq = 0; rq < 4; ++rq) { v2u w0, w1;
            w0.x = cvtpk(A.o0[4 * rq], A.o0[4 * rq + 1]); w0.y = cvtpk(A.o0[4 * rq + 2], A.o0[4 * rq + 3]);
            w1.x = cvtpk(A.o1[4 * rq], A.o1[4 * rq + 1]); w1.y = cvtpk(A.o1[4 * rq + 2], A.o1[4 * rq + 3]);
            *(v2u*)(op + 8 * rq + 4 * hi) = w0; *(v2u*)(op + 32 + 8 * rq + 4 * hi) = w1; }
    }
}

DI void phase_nsa_selwin_mfma(const Args& a, Frame& F, int j) {
    enter(F);
    const bf16* HB = (const bf16*)(F.ws + WS_HB); const float* OC = (const float*)(F.ws + MX_OC); float* OSB = (float*)(F.ws + MX_OSB);
    const unsigned long long* SELM = (const unsigned long long*)(F.ws + MX_SELM); bf16* CAT = (bf16*)(F.ws + WS_CAT);
    const float* rel = a.in[I_REL]; const float* gb = a.in[I_NSA_GB] + (size_t)j * 36;
    float* btab = (float*)(F.lds + 12 * SWTILE);
    const int lane = F.lane, r32 = lane & 31, hi = lane >> 5, w = F.wave;
    const int nunits = BATCH * 12 * 16;
    for (int it = 0;; ++it) {
        const int u0 = it * F.G + F.bid; if (u0 >= nunits) break;
        const int qraw = u0 & 15, bh = u0 >> 4, qt = (it & 1) ? 15 - qraw : qraw, b = bh / 12, hh = bh % 12, g = hh / 3;
        const int c0 = qt * 4, cw = c0 + (w >> 1), cmax = c0 + 3;
        const int tq = qt * 256 + w * 32 + r32, t = b * SEQ + tq;
        __syncthreads();
        { int tl = F.tid; asm volatile("" : "+v"(tl)); if (tl < 256) btab[tl] = tl <= 191 ? rel[t5_bucket(191 - tl) * 12 + hh] * LOG2E : 0.f; }
        const float cfar = rel[31 * 12 + hh] * LOG2E;
        bf16x8 qf[4]; load_q(qf, HB + (size_t)t * HC + NQ + hh * 64, hi);
        const unsigned long long sel = SELM[(size_t)t * 4 + g];
#pragma unroll 1
        for (int pp = 0; pp < 2 + ((a.probe >> 17) & 1) + ((a.probe >> 18) & 1); ++pp) {
            const int pass = ((a.probe >> 17) & 1) ? (pp <= 1 ? 0 : 1) : (pp == 0 ? 0 : 1);
            const bf16* Kg = HB + (size_t)(b * SEQ) * HC + (pass ? NKW : NKS) + g * 64; const bf16* Vg = HB + (size_t)(b * SEQ) * HC + (pass ? NVW : NVS) + g * 64;
            const int klo = pass ? (c0 >= 8 ? c0 - 8 : 0) : 0, ntile = cmax - klo + 1, npair = (ntile + 1) >> 1;
            AttnAcc A; attn_init(A);
#define SW_ISSUE(ip) do { const int kta_ = cmax - 2 * (ip), bq_ = (ip) % 3; unsigned char* kb_ = F.lds + bq_ * 4 * SWTILE; \
                kv_dma(Kg + (size_t)kta_ * 64 * HC, Vg + (size_t)kta_ * 64 * HC, HC, kb_, kb_ + 2 * SWTILE, w, lane); \
                if (kta_ - 1 >= klo) kv_dma(Kg + (size_t)(kta_ - 1) * 64 * HC, Vg + (size_t)(kta_ - 1) * 64 * HC, HC, kb_ + SWTILE, kb_ + 3 * SWTILE, w, lane); } while (0)
            asm volatile("s_waitcnt vmcnt(0) lgkmcnt(0)" ::: "memory"); __builtin_amdgcn_s_barrier();
            SW_ISSUE(0);
            if (npair > 1) { SW_ISSUE(1); if (cmax - 3 >= klo) asm volatile("s_waitcnt vmcnt(4)" ::: "memory"); else asm volatile("s_waitcnt vmcnt(2)" ::: "memory"); }
            else asm volatile("s_waitcnt vmcnt(0)" ::: "memory");
            __builtin_amdgcn_s_barrier();
#pragma unroll 1
            for (int i = 0; i < npair; ++i) {
                const int kt0 = cmax - 2 * i, kt1 = kt0 - 1; const bool has1 = kt1 >= klo;
                const int nahead = (i + 2 < npair) ? ((cmax - 2 * (i + 2) - 1 >= klo) ? 4 : 2) : 0;
                if (i + 2 < npair) SW_ISSUE(i + 2);
                const unsigned char* K0 = F.lds + (i % 3) * 4 * SWTILE; const unsigned char* K1 = K0 + SWTILE; const unsigned char* V0 = K0 + 2 * SWTILE; const unsigned char* V1 = K0 + 3 * SWTILE;
                const bool in0 = pass ? (kt0 <= cw && kt0 + 8 >= cw) : (kt0 <= cw);
                const bool in1 = has1 && (pass ? (kt1 <= cw && kt1 + 8 >= cw) : (kt1 <= cw));
                const bool en0 = pass ? true : (((sel >> kt0) & 1ull) != 0ull), en1 = pass ? true : (((sel >> (kt1 < 0 ? 0 : kt1)) & 1ull) != 0ull);
                const bool gen0 = (kt0 + 2 >= cw) || (pass && kt0 + 8 == cw), gen1 = (kt1 + 2 >= cw) || (pass && kt1 + 8 == cw);
                if (in0 && in1 && !gen0 && !gen1) {
                    if (__any(en0 || en1)) attn_tile2<true>(K0, V0, K1, V1, qf, A, lane, en0 ? cfar : -1e30f, en1 ? cfar : -1e30f);
                } else {
                    if (in0 && __any(en0)) { const int dq = tq - kt0 * 64;
                        if (gen0) attn_tile<true, false, true>(K0, V0, qf, A, lane, en0, dq, kt0 == cw ? 2 : (kt0 + 2 >= cw ? 1 : 3), btab, cfar);
                        else attn_tile<false, false, true>(K0, V0, qf, A, lane, en0, dq, 0, btab, cfar); }
                    if (in1 && __any(en1)) { const int dq = tq - kt1 * 64;
                        if (gen1) attn_tile<true, false, true>(K1, V1, qf, A, lane, en1, dq, kt1 == cw ? 2 : (kt1 + 2 >= cw ? 1 : 3), btab, cfar);
                        else attn_tile<false, false, true>(K1, V1, qf, A, lane, en1, dq, 0, btab, cfar); }
                }
                if (nahead == 4) asm volatile("s_waitcnt vmcnt(4) lgkmcnt(0)" ::: "memory"); else if (nahead == 2) asm volatile("s_waitcnt vmcnt(2) lgkmcnt(0)" ::: "memory"); else asm volatile("s_waitcnt vmcnt(0) lgkmcnt(0)" ::: "memory");
                __builtin_amdgcn_s_barrier();
            }
#undef SW_ISSUE
            attn_finish(A);
            if (pass == 0) {
                float* sp = OSB + (size_t)t * TOKW + hh * 64;
#pragma unroll
                for (int rq = 0; rq < 4; ++rq) { *(f32x4*)(sp + 8 * rq + 4 * hi) = (f32x4){A.o0[4 * rq], A.o0[4 * rq + 1], A.o0[4 * rq + 2], A.o0[4 * rq + 3]};
                    *(f32x4*)(sp + 32 + 8 * rq + 4 * hi) = (f32x4){A.o1[4 * rq], A.o1[4 * rq + 1], A.o1[4 * rq + 2], A.o1[4 * rq + 3]}; }
            } else {
                const bf16* glp = HB + (size_t)t * HC + NGL + hh * 3;
                const float g0 = fsigmoid(bf2f(glp[0]) + gb[hh * 3]), g1 = fsigmoid(bf2f(glp[1]) + gb[hh * 3 + 1]), g2 = fsigmoid(bf2f(glp[2]) + gb[hh * 3 + 2]);
                const float* oc = OC + (size_t)t * TOKW + hh * 64; const float* osp = OSB + (size_t)t * TOKW + hh * 64; bf16* op = CAT + (size_t)t * D + hh * 64;
#pragma unroll
                for (int rq = 0; rq < 4; ++rq) {
                    const f32x4 c0v = *(const f32x4*)(oc + 8 * rq + 4 * hi), c1v = *(const f32x4*)(oc + 32 + 8 * rq + 4 * hi);
                    const f32x4 s0v = *(const f32x4*)(osp + 8 * rq + 4 * hi), s1v = *(const f32x4*)(osp + 32 + 8 * rq + 4 * hi);
                    float v0[4], v1[4];
#pragma unroll
                    for (int e = 0; e < 4; ++e) { v0[e] = g0 * c0v[e] + g1 * s0v[e] + g2 * A.o0[4 * rq + e]; v1[e] = g0 * c1v[e] + g1 * s1v[e] + g2 * A.o1[4 * rq + e]; }
                    v2u w0, w1; w0.x = cvtpk(v0[0], v0[1]); w0.y = cvtpk(v0[2], v0[3]); w1.x = cvtpk(v1[0], v1[1]); w1.y = cvtpk(v1[2], v1[3]);
                    *(v2u*)(op + 8 * rq + 4 * hi) = w0; *(v2u*)(op + 32 + 8 * rq + 4 * hi) = w1;
                }
            }
        }
    }
}

DI void phase_nsa_cmpA(const Args& a, Frame& F, int j) {
    enter(F);
    const bf16* HB = (const bf16*)(F.ws + WS_HB); const float* pe = a.in[I_NSA_PE] + (size_t)j * 2 * 32 * 64;
    bf16* CA = (bf16*)(F.ws + MX_CMPA);
    for (int blk = F.bid; blk < 8192; blk += 4 * F.G) {
        v4u hr[4]; int rowv[4], c8v[4], whichv[4]; bool ok[4];
#pragma unroll
        for (int q = 0; q < 4; ++q) { const int bq = blk + q * F.G; const size_t i = (size_t)bq * 512 + F.tid;
            const int c8 = (int)(i & 255), row = (int)((i >> 8) & 8191), which = (int)(i >> 21);
            rowv[q] = row; c8v[q] = c8; whichv[q] = which; ok[q] = bq < 8192 && row < BATCH * NC * 4;
            if (ok[q]) { const int l = c8 >> 3, d = (c8 & 7) * 8, g = row & 3, bn = row >> 2, b = bn / NC, n = bn % NC;
                hr[q] = *(const v4u*)(HB + (size_t)(b * SEQ + 16 * n + l) * HC + (which ? NVC : NKC) + g * 64 + d); } }
#pragma unroll
        for (int q = 0; q < 4; ++q) { if (blk + q * F.G >= 8192) continue;
            v4u o = {0u, 0u, 0u, 0u};
            if (ok[q]) { const int l = c8v[q] >> 3, d = (c8v[q] & 7) * 8; const float* pp = pe + (size_t)whichv[q] * 2048 + l * 64 + d;
                const f32x4 p0 = *(const f32x4*)pp, p1 = *(const f32x4*)(pp + 4);
                o.x = pk2(bf2f((unsigned short)(hr[q].x & 0xffff)) + p0[0], bf2f((unsigned short)(hr[q].x >> 16)) + p0[1]); o.y = pk2(bf2f((unsigned short)(hr[q].y & 0xffff)) + p0[2], bf2f((unsigned short)(hr[q].y >> 16)) + p0[3]);
                o.z = pk2(bf2f((unsigned short)(hr[q].z & 0xffff)) + p1[0], bf2f((unsigned short)(hr[q].z >> 16)) + p1[1]); o.w = pk2(bf2f((unsigned short)(hr[q].w & 0xffff)) + p1[2], bf2f((unsigned short)(hr[q].w >> 16)) + p1[3]); }
            *(v4u*)(CA + ((size_t)whichv[q] * 8192 + rowv[q]) * 2048 + c8v[q] * 8) = o; }
    }
}

constexpr size_t MX_RLO = 2320 * MiB;
constexpr size_t MX_RLORA = 2336 * MiB;
constexpr size_t WS_WLORA = 42 * MiB;
DI void phase_rwkv_lo(const Args& a, Frame& F) {
    enter(F);
    const bf16* HB = (const bf16*)(F.ws + WS_HB); bf16* LO = (bf16*)(F.ws + MX_RLO); const float* mu = a.in[I_RW_MU];
    const int c8 = (F.tid & 31) * 8, seg = c8 < 64 ? 0 : c8 < 128 ? 1 : 2, col = seg == 0 ? RWL + c8 : seg == 1 ? RAL + (c8 - 64) : RGL + (c8 - 128);
    const f32x4 m0 = *(const f32x4*)(mu + col), m1 = *(const f32x4*)(mu + col + 4);
    const float mv[8] = {m0[0], m0[1], m0[2], m0[3], m1[0], m1[1], m1[2], m1[3]};
    for (int blk = F.bid; blk < T / 64; blk += F.G) {
        v4u cur[4], prv[4];
#pragma unroll
        for (int q = 0; q < 4; ++q) { const size_t t = (size_t)blk * 64 + q * 16 + (F.tid >> 5); const bf16* hp = HB + t * HC + col;
            cur[q] = *(const v4u*)hp; prv[q] = *(const v4u*)((t % SEQ) ? hp - HC : hp); }
#pragma unroll
        for (int q = 0; q < 4; ++q) { const size_t t = (size_t)blk * 64 + q * 16 + (F.tid >> 5); const bool first = (t % SEQ) == 0;
            v4u o;
#pragma unroll
            for (int d = 0; d < 4; ++d) { const unsigned cr = cur[q][d], pr = first ? 0u : prv[q][d];
                const float ha = __builtin_bit_cast(float, cr << 16), hb = __builtin_bit_cast(float, cr & 0xffff0000u), pa = __builtin_bit_cast(float, pr << 16), pb = __builtin_bit_cast(float, pr & 0xffff0000u);
                const float xa = ha + (pa - ha) * mv[2 * d], xb = hb + (pb - hb) * mv[2 * d + 1];
                o[d] = pk2(seg == 0 ? ftanh(xa) : seg == 1 ? xa : fsigmoid(xa), seg == 0 ? ftanh(xb) : seg == 1 ? xb : fsigmoid(xb)); }
            *(v4u*)(LO + t * 256 + c8) = o; }
    }
}
DI void phase_rwkv_out(const Args& a, Frame& F) {
    enter(F);
    const bf16* HB = (const bf16*)(F.ws + WS_HB); const bf16* LR = (const bf16*)(F.ws + MX_RLORA); const float* RO = (const float*)(F.ws + MX_RO); const float* BON = (const float*)(F.ws + MX_RBON);
    bf16* CAT = (bf16*)(F.ws + WS_CAT); const float* lnw = a.in[I_RW_LNW]; const float* lnb = a.in[I_RW_LNB]; const float* mu = a.in[I_RW_MU];
    typedef unsigned short u16x4 __attribute__((ext_vector_type(4))); typedef unsigned u32x2_ __attribute__((ext_vector_type(2)));
    const int gw = F.bid * 8 + F.wave, hq = F.lane >> 4, k0 = (F.lane & 15) * 4;
    for (int i = gw; i < T / 2; i += F.G * 8) {
        f32x4 x[2][3]; u16x4 hv[2][3], pv[2][3], gg[2][3]; float bn[2][3];
#pragma unroll
        for (int e = 0; e < 2; ++e) { const size_t t = (size_t)i * 2 + e; const bool first = (t % SEQ) == 0;
#pragma unroll
            for (int g = 0; g < 3; ++g) { const int head = hq + 4 * g, c = head * 64 + k0; const bf16* hp = HB + t * HC + RV + c;
                x[e][g] = *(const f32x4*)(RO + t * TOKW + c); hv[e][g] = *(const u16x4*)hp; pv[e][g] = *(const u16x4*)(first ? hp : hp - HC);
                gg[e][g] = *(const u16x4*)(LR + t * 2304 + 1536 + c); bn[e][g] = BON[t * 12 + head]; } }
#pragma unroll
        for (int e = 0; e < 2; ++e) { const size_t t = (size_t)i * 2 + e; const bool first = (t % SEQ) == 0;
#pragma unroll
            for (int g = 0; g < 3; ++g) { const int c = (hq + 4 * g) * 64 + k0; const f32x4 xv = x[e][g];
                float sm = xv[0] + xv[1] + xv[2] + xv[3];
                sm = row_sum16(sm);
                const float mean = sm * (1.0f / 64.0f); const f32x4 dx = xv - mean;
                float vs = dx[0] * dx[0] + dx[1] * dx[1] + dx[2] * dx[2] + dx[3] * dx[3];
                vs = row_sum16(vs);
                const float rs = __builtin_amdgcn_rsqf(vs * opq(1.0f / 64.0f) + opq(64e-5f));
                const f32x4 lw4 = *(const f32x4*)(lnw + c), lb4 = *(const f32x4*)(lnb + c), mu4 = *(const f32x4*)(mu + RV + c);
                float y[4];
#pragma unroll
                for (int d = 0; d < 4; ++d) { const float h = bf2f(hv[e][g][d]), p = first ? 0.f : bf2f(pv[e][g][d]); const float v = h + (p - h) * mu4[d];
                    y[d] = (dx[d] * rs * lw4[d] + lb4[d] + bn[e][g] * v) * bf2f(gg[e][g][d]); }
                *(u32x2_*)(CAT + t * D + c) = (u32x2_){pk2(y[0], y[1]), pk2(y[2], y[3])}; } }
    }
}

constexpr size_t MX_GQD = WS_MIX + 144 * MiB;
constexpr size_t MX_GKD = WS_MIX + 168 * MiB;
constexpr size_t MX_GKD2 = WS_MIX + 192 * MiB;
constexpr size_t MX_GEBL = WS_MIX + 216 * MiB;

DI void phase_gla_prep(const Args& a, Frame& F) {
    enter(F);
    const bf16* HB = (const bf16*)(F.ws + WS_HB);
    bf16* QD = (bf16*)(F.ws + MX_GQD); bf16* KD = (bf16*)(F.ws + MX_GKD); bf16* KD2 = (bf16*)(F.ws + MX_GKD2); float* EBL = (float*)(F.ws + MX_GEBL);
    const float* wa2 = a.in[I_GLA_WA2]; const float* ba = a.in[I_GLA_BA];
    float* AL = (float*)F.lds; float* BL = (float*)(F.lds + 4096); float* BC = (float*)(F.lds + 8192);
    const int tid = F.tid, cB = tid < 384 ? tid : 0;
    float w[16];
#pragma unroll
    for (int k = 0; k < 16; ++k) w[k] = wa2[k * 384 + cB];
    const float bac = ba[cB];
    for (int bn = F.bid; bn < BATCH * 64; bn += F.G) {
        const size_t t0 = (size_t)bn * 64;
        lds_barrier();
        v4u qv[6], kv[6];
#pragma unroll
        for (int q = 0; q < 6; ++q) { const int item = tid + 512 * q, s = item / 48, c8 = item % 48; const bf16* hp = HB + (t0 + s) * HC + c8 * 8;
            qv[q] = *(const v4u*)(hp + GQ); kv[q] = *(const v4u*)(hp + GK); }
        if (tid < 128) { const int tok = tid >> 1, hf = tid & 1; const v4u x = *(const v4u*)(HB + (t0 + tok) * HC + GALR + hf * 8); float* d = AL + tok * 16 + hf * 8;
            *(f32x4*)d = (f32x4){__builtin_bit_cast(float, x.x << 16), __builtin_bit_cast(float, x.x & 0xffff0000u), __builtin_bit_cast(float, x.y << 16), __builtin_bit_cast(float, x.y & 0xffff0000u)};
            *(f32x4*)(d + 4) = (f32x4){__builtin_bit_cast(float, x.z << 16), __builtin_bit_cast(float, x.z & 0xffff0000u), __builtin_bit_cast(float, x.w << 16), __builtin_bit_cast(float, x.w & 0xffff0000u)}; }
        lds_barrier();
        if (tid < 384) { float bc = 0.f;
#pragma unroll 4
            for (int s = 0; s < 64; ++s) { const f32x4* al = (const f32x4*)(AL + s * 16); float x = bac;
#pragma unroll
                for (int k4 = 0; k4 < 4; ++k4) { const f32x4 v = al[k4]; x += v[0] * w[4 * k4] + v[1] * w[4 * k4 + 1] + v[2] * w[4 * k4 + 2] + v[3] * w[4 * k4 + 3]; }
                bc += -fsoftplus(-x) * (1.0f / 16.0f); BC[s * 384 + tid] = bc; }
            BL[tid] = bc; EBL[(size_t)bn * 384 + tid] = fexp(bc); }
        lds_barrier();
#pragma unroll
        for (int q = 0; q < 6; ++q) { const int item = tid + 512 * q, s = item / 48, c = (item % 48) * 8; const size_t o = (t0 + s) * 384 + c;
            const f32x4 b0 = *(const f32x4*)(BC + s * 384 + c), b1 = *(const f32x4*)(BC + s * 384 + c + 4), l0 = *(const f32x4*)(BL + c), l1 = *(const f32x4*)(BL + c + 4);
            const float bcv[8] = {b0[0], b0[1], b0[2], b0[3], b1[0], b1[1], b1[2], b1[3]}, blv[8] = {l0[0], l0[1], l0[2], l0[3], l1[0], l1[1], l1[2], l1[3]};
            v4u oq, ok, o2;
#pragma unroll
            for (int d = 0; d < 4; ++d) { const unsigned qr = qv[q][d], kr = kv[q][d];
                const float bca = bcv[2 * d], bcb = bcv[2 * d + 1], bla = blv[2 * d], blb = blv[2 * d + 1];
                const float qa = __builtin_bit_cast(float, qr << 16) * 0.10206207261596575f, qb = __builtin_bit_cast(float, qr & 0xffff0000u) * 0.10206207261596575f;
                const float ka = __builtin_bit_cast(float, kr << 16), kb = __builtin_bit_cast(float, kr & 0xffff0000u);
                oq[d] = pk2(qa * fexp(bca), qb * fexp(bcb)); ok[d] = pk2(ka * fexp(-bca), kb * fexp(-bcb)); o2[d] = pk2(ka * fexp(bla - bca), kb * fexp(blb - bcb)); }
            *(v4u*)(QD + o) = oq; *(v4u*)(KD + o) = ok; *(v4u*)(KD2 + o) = o2; }
    }
}
constexpr int GVP = 400;
DI void phase_gla_intra(Frame& F, int b0) {
    enter(F);
    const bf16* HB = (const bf16*)(F.ws + WS_HB); const bf16* QD = (const bf16*)(F.ws + MX_GQD); const bf16* KD = (const bf16*)(F.ws + MX_GKD); float* GO = (float*)(F.ws + MX_GO);
    unsigned char* Vl = F.lds;
    const int lane = F.lane, r32 = lane & 31, hi = lane >> 5, w = F.wave;
    if (F.bid < b0) return;
    for (int u = F.bid - b0; u < BATCH * 64 * 4; u += F.G - b0) {
        const int h = u & 3, bn = u >> 2; const size_t t0 = (size_t)bn * 64;
        lds_barrier();
        for (int i = F.tid; i < 64 * 24; i += 512) { const int row = i / 24, ch = i % 24; *(v4u*)(Vl + row * GVP + ch * 16) = *(const v4u*)(HB + (t0 + row) * HC + GV + h * 192 + ch * 8); }
        lds_barrier();
        if (w < 6) {
            bf16x8 kf[2][6];
#pragma unroll
            for (int st = 0; st < 2; ++st)
#pragma unroll
                for (int kc = 0; kc < 6; ++kc) kf[st][kc] = *(const bf16x8*)(KD + (t0 + 32 * st + r32) * 384 + h * 96 + 16 * kc + 8 * hi);
#pragma unroll
            for (int ct = 0; ct < 2; ++ct) {
                bf16x8 qf[6];
#pragma unroll
                for (int kc = 0; kc < 6; ++kc) qf[kc] = *(const bf16x8*)(QD + (t0 + 32 * ct + r32) * 384 + h * 96 + 16 * kc + 8 * hi);
                f32x16 o;
#pragma unroll
                for (int r = 0; r < 16; ++r) o[r] = 0.f;
#pragma unroll
                for (int st = 0; st <= ct; ++st) {
                    f32x16 at;
#pragma unroll
                    for (int r = 0; r < 16; ++r) at[r] = 0.f;
#pragma unroll
                    for (int kc = 0; kc < 6; ++kc) at = MFMA32(kf[st][kc], qf[kc], at);
                    if (st == ct) {
#pragma unroll
                        for (int r = 0; r < 16; ++r) at[r] = (crow(r, hi) <= r32) ? at[r] : 0.f;
                    }
#pragma unroll
                    for (int s2 = 0; s2 < 2; ++s2) o = MFMA32(frag_col44(Vl, GVP, 32 * st + 16 * s2 + 4 * hi, 32 * w, lane), pack_acc(at, s2), o);
                }
                float* op = GO + (t0 + 32 * ct + r32) * TOKW + h * 192 + 32 * w;
#pragma unroll
                for (int rq = 0; rq < 4; ++rq) *(f32x4*)(op + 8 * rq + 4 * hi) = (f32x4){o[4 * rq], o[4 * rq + 1], o[4 * rq + 2], o[4 * rq + 3]};
            }
        }
    }
}
constexpr int GQP = 208;
constexpr int GEOFF = 2 * 64 * GQP + 64 * GVP;
constexpr int GBUF = GEOFF + 512;
constexpr size_t MX_GOI = WS_MIX + 224 * MiB;
DI void phase_gla_seq(Frame& F) {
    enter(F);
    const unsigned char* HBc = F.ws + WS_HB; const unsigned char* QDc = F.ws + MX_GQD; const unsigned char* KD2c = F.ws + MX_GKD2; const float* EBL = (const float*)(F.ws + MX_GEBL);
    float* GOI = (float*)(F.ws + MX_GOI);
    const int lane = F.lane, r32 = lane & 31, hi = lane >> 5, w = F.wave;
    unsigned gA[3], lA[3], gB[3], lB[3]; bool isq[3];
#pragma unroll
    for (int q = 0; q < 3; ++q) { const int i = F.tid + 512 * q; isq[q] = i < 768; const int i2 = isq[q] ? i : i - 768, row = i2 / 12, ch = i2 % 12;
        gA[q] = (unsigned)(row * 384 + ch * 8) * 2u; lA[q] = (unsigned)((isq[q] ? 0 : 64 * GQP) + row * GQP + ch * 16);
        const int rowv = i / 24, chv = i % 24; gB[q] = (unsigned)(rowv * HC + chv * 8) * 2u; lB[q] = (unsigned)(128 * GQP + rowv * GVP + chv * 16); }
    for (int u = F.bid; u < BATCH * 4; u += F.G) {
        const int b = u >> 2, h = u & 3;
        f32x16 S[3];
#pragma unroll
        for (int kt = 0; kt < 3; ++kt)
#pragma unroll
            for (int r = 0; r < 16; ++r) S[kt][r] = 0.f;
        v4u sr[3], sre = {0u, 0u, 0u, 0u};
#define GLA_LOAD_A(n) do { const size_t o_ = ((size_t)(b * 64 + (n)) * 64 * 384 + h * 96) * 2; _Pragma("unroll") for (int q_ = 0; q_ < 3; ++q_) sr[q_] = *(const v4u*)((isq[q_] ? QDc : KD2c) + o_ + gA[q_]); \
            if (F.tid < 24) sre = *(const v4u*)(EBL + (size_t)(b * 64 + (n)) * 384 + h * 96 + F.tid * 4); } while (0)
#define GLA_LOAD_B(n) do { const size_t o_ = ((size_t)(b * 64 + (n)) * 64 * HC + GV + h * 192) * 2; _Pragma("unroll") for (int q_ = 0; q_ < 3; ++q_) sr[q_] = *(const v4u*)(HBc + o_ + gB[q_]); } while (0)
#define GLA_STORE_A(buf) do { _Pragma("unroll") for (int q_ = 0; q_ < 3; ++q_) *(v4u*)(F.lds + (buf) * GBUF + lA[q_]) = sr[q_]; if (F.tid < 24) *(v4u*)(F.lds + (buf) * GBUF + GEOFF + F.tid * 16) = sre; } while (0)
#define GLA_STORE_B(buf) do { _Pragma("unroll") for (int q_ = 0; q_ < 3; ++q_) *(v4u*)(F.lds + (buf) * GBUF + lB[q_]) = sr[q_]; } while (0)
        lds_barrier();
        GLA_LOAD_A(0); GLA_STORE_A(0); GLA_LOAD_B(0); GLA_STORE_B(0);
        lds_barrier();
#pragma unroll 1
        for (int n = 0; n < 64; ++n) {
            const int buf = n & 1; const bool more = n + 1 < 64;
            const unsigned char* Ql = F.lds + buf * GBUF; const unsigned char* K2l = Ql + 64 * GQP; const unsigned char* Vl = Ql + 128 * GQP;
            if (more) GLA_LOAD_A(n + 1);
            if (w < 6) {
                bf16x8 Sp[3][2];
#pragma unroll
                for (int kt = 0; kt < 3; ++kt) { Sp[kt][0] = pack_acc(S[kt], 0); Sp[kt][1] = pack_acc(S[kt], 1); }
#pragma unroll
                for (int ct = 0; ct < 2; ++ct) {
                    f32x16 o;
#pragma unroll
                    for (int r = 0; r < 16; ++r) o[r] = 0.f;
#pragma unroll
                    for (int kt = 0; kt < 3; ++kt)
#pragma unroll
                        for (int s2 = 0; s2 < 2; ++s2) {
                            const unsigned char* qp = Ql + (32 * ct + r32) * GQP + (32 * kt + 16 * s2 + 4 * hi) * 2;
                            const v2u lo = *(const v2u*)qp, hi8 = *(const v2u*)(qp + 16);
                            const v4u qa = {lo.x, lo.y, hi8.x, hi8.y};
                            o = MFMA32(__builtin_bit_cast(bf16x8, qa), Sp[kt][s2], o);
                        }
                    float* op = GOI + ((((size_t)(b * 64 + n) * 4 + h) * 6 + w) * 2 + ct) * 1024 + lane;
#pragma unroll
                    for (int r = 0; r < 16; ++r) op[r * 64] = o[r];
                    __builtin_amdgcn_sched_barrier(0);
                }
            }
            if (more) { GLA_STORE_A(buf ^ 1); GLA_LOAD_B(n + 1); }
            if (w < 6) {
#pragma unroll
                for (int kt = 0; kt < 3; ++kt) {
                    const float* eb = (const float*)(Ql + GEOFF) + 32 * kt + 4 * hi;
#pragma unroll
                    for (int rq = 0; rq < 4; ++rq) { const f32x4 e4 = *(const f32x4*)(eb + 8 * rq);
                        S[kt][4 * rq] *= e4[0]; S[kt][4 * rq + 1] *= e4[1]; S[kt][4 * rq + 2] *= e4[2]; S[kt][4 * rq + 3] *= e4[3]; }
#pragma unroll
                    for (int st = 0; st < 4; ++st)
                        S[kt] = MFMA32(frag_col8(K2l, GQP, 16 * st + 8 * hi, 32 * kt, lane), frag_col8(Vl, GVP, 16 * st + 8 * hi, 32 * w, lane), S[kt]);
                    __builtin_amdgcn_sched_barrier(0);
                }
            }
            if (more) GLA_STORE_B(buf ^ 1);
            lds_barrier();
        }
#undef GLA_LOAD_A
#undef GLA_LOAD_B
#undef GLA_STORE_A
#undef GLA_STORE_B
    }
}
DI void phase_gla_out2(const Args& a, Frame& F) {
    enter(F);
    const bf16* HB = (const bf16*)(F.ws + WS_HB); const float* GO = (const float*)(F.ws + MX_GO); const float* GOI = (const float*)(F.ws + MX_GOI); bf16* CAT = (bf16*)(F.ws + WS_CAT);
    const float* nw = a.in[I_GLA_NW]; const float* bog = a.in[I_GLA_BOG];
    typedef unsigned short u16x4 __attribute__((ext_vector_type(4))); typedef unsigned u32x2_ __attribute__((ext_vector_type(2)));
    const int gw = F.bid * 8 + F.wave, h = F.lane >> 4, v0 = (F.lane & 15) * 4;
    f32x4 nwv[3], bgv[3];
#pragma unroll
    for (int e = 0; e < 3; ++e) { nwv[e] = *(const f32x4*)(nw + e * 64 + v0); bgv[e] = *(const f32x4*)(bog + h * 192 + e * 64 + v0); }
    for (int i = gw; i < T / 2; i += F.G * 8) {
        f32x4 o[2][3], oi[2][3]; u16x4 og[2][3];
#pragma unroll
        for (int e2 = 0; e2 < 2; ++e2) { const size_t t = (size_t)i * 2 + e2; const int bn = (int)(t >> 6), c = (int)(t & 63), ct = c >> 5, cc = c & 31, hi2 = (cc >> 2) & 1, reg = (cc & 3) + 4 * (cc >> 3);
#pragma unroll
            for (int e = 0; e < 3; ++e) { const int v = e * 64 + v0, w2 = v >> 5;
                o[e2][e] = *(const f32x4*)(GO + t * TOKW + h * 192 + v);
                oi[e2][e] = *(const f32x4*)(GOI + ((((size_t)bn * 4 + h) * 6 + w2) * 2 + ct) * 1024 + reg * 64 + hi2 * 32 + (v & 31));
                og[e2][e] = *(const u16x4*)(HB + t * HC + GOG + h * 192 + v); } }
#pragma unroll
        for (int e2 = 0; e2 < 2; ++e2) { const size_t t = (size_t)i * 2 + e2;
            float ss = 0.f;
#pragma unroll
            for (int e = 0; e < 3; ++e) { o[e2][e] += oi[e2][e]; const f32x4 x = o[e2][e]; ss += x[0] * x[0] + x[1] * x[1] + x[2] * x[2] + x[3] * x[3]; }
            ss = row_sum16(ss);
            const float rs = 1.0f / sqrtf(ss * opq(1.0f / 192.0f) + opq(LN_EPS));
            bf16* cp = CAT + t * D + h * 192;
#pragma unroll
            for (int e = 0; e < 3; ++e) { float y[4];
#pragma unroll
                for (int d = 0; d < 4; ++d) { const float z = bf2f(og[e2][e][d]) + bgv[e][d]; y[d] = o[e2][e][d] * rs * nwv[e][d] * (z * fsigmoid(z)); }
                *(u32x2_*)(cp + e * 64 + v0) = (u32x2_){pk2(y[0], y[1]), pk2(y[2], y[3])}; } }
    }
}

constexpr size_t MX_RA3 = 1776 * MiB;
constexpr size_t MX_RA1 = 1872 * MiB;
constexpr size_t MX_ROL = 1920 * MiB;
constexpr size_t MX_RSL = 1968 * MiB;
constexpr int RFP = 68;
constexpr int RBP = 144;
constexpr int RMP = 80;
constexpr int RL_LW = 0, RL_CUM = 8704, RL_AF = 17408, RL_RF = 26112, RL_KPF = 34816, RL_BBF = 43520;
constexpr int RL_AT = 52224, RL_RT = 56832, RL_BT = 61440, RL_KT = 66048, RL_BP = 70656, RL_VB = 75264;
constexpr int RL_MABT = 79872;
constexpr int RL_MAK = 83968;
constexpr int RL_MBR = 88192;
constexpr int RL_MKR = 90752;
constexpr int RL_W1 = 94848;
constexpr int RL_W2 = 99968;
constexpr int RL_PC = 102528;
constexpr int RL_MP = 102784;
constexpr int RL_XL = 79872;

DI void phase_rwkv_chunk(const Args& a, Frame& F) {
    enter(F);
    const bf16* HB = (const bf16*)(F.ws + WS_HB); const bf16* LR = (const bf16*)(F.ws + MX_RLORA); float* BON = (float*)(F.ws + MX_RBON);
    const float* mu = a.in[I_RW_MU], *w0 = a.in[I_RW_W0], *a0 = a.in[I_RW_A0], *k_k = a.in[I_RW_KK], *k_a = a.in[I_RW_KA], *r_k = a.in[I_RW_RK];
    unsigned char* L = F.lds;
    float* LW = (float*)(L + RL_LW), *CUM = (float*)(L + RL_CUM), *AF = (float*)(L + RL_AF), *RF = (float*)(L + RL_RF), *KPF = (float*)(L + RL_KPF), *BBF = (float*)(L + RL_BBF);
    float* MKR = (float*)(L + RL_MKR), *PC = (float*)(L + RL_PC);
    const int w = F.wave;
    typedef unsigned short u16x4 __attribute__((ext_vector_type(4)));
    u16x4 hr4, hk4, hv4, pr4, pk4, pv4, aw4, aa4; f32x4 mur, muk, muv, w0c, a0c, kkc, kac, rkc;
#define RW_FETCH(uu) do { const int n_ = (uu) & 127, bh_ = (uu) >> 7, b_ = bh_ / 12, head_ = bh_ % 12; int ln_ = F.lane; asm volatile("" : "+v"(ln_)); \
        const int c0_ = head_ * 64 + (ln_ & 15) * 4; const size_t t_ = (size_t)b_ * SEQ + 32 * n_ + w * 4 + (ln_ >> 4); const bool first_ = (t_ % SEQ) == 0; \
        const bf16* hp_ = HB + t_ * HC + c0_; const bf16* pp_ = first_ ? hp_ : hp_ - HC; const bf16* lr_ = LR + t_ * 2304 + c0_; \
        hr4 = *(const u16x4*)(hp_ + RR); hk4 = *(const u16x4*)(hp_ + RK); hv4 = *(const u16x4*)(hp_ + RV); pr4 = *(const u16x4*)(pp_ + RR); pk4 = *(const u16x4*)(pp_ + RK); pv4 = *(const u16x4*)(pp_ + RV); \
        aw4 = *(const u16x4*)lr_; aa4 = *(const u16x4*)(lr_ + 768); \
        mur = *(const f32x4*)(mu + RR + c0_); muk = *(const f32x4*)(mu + RK + c0_); muv = *(const f32x4*)(mu + RV + c0_); \
        w0c = *(const f32x4*)(w0 + c0_); a0c = *(const f32x4*)(a0 + c0_); kkc = *(const f32x4*)(k_k + c0_); kac = *(const f32x4*)(k_a + c0_); rkc = *(const f32x4*)(r_k + c0_); } while (0)
    if (F.bid < BATCH * 12 * 128) RW_FETCH(F.bid);
    for (int u = F.bid; u < BATCH * 12 * 128; u += F.G) {
        int lane_ = F.lane; asm volatile("" : "+v"(lane_));
        const int lane = lane_, r32 = lane & 31, hi = lane >> 5;
        const int n = u & 127, bh = u >> 7, b = bh / 12, head = bh % 12; const size_t t0 = (size_t)b * SEQ + 32 * n;
        const int tidl = w * 64 + lane;
        lds_barrier();
        {
            const int tt = w * 4 + (lane >> 4), k0 = (lane & 15) * 4, o = tt * RFP + k0; const size_t t = t0 + tt;
            const bool first = (t % SEQ) == 0;
            f32x4 r, kx, wl, av, kk0; float s2 = 0.f; unsigned vb[4];
#pragma unroll
            for (int q = 0; q < 4; ++q) {
                const float hr = bf2f(hr4[q]), hk = bf2f(hk4[q]), hv = bf2f(hv4[q]);
                r[q] = hr + ((first ? 0.f : bf2f(pr4[q])) - hr) * mur[q];
                kx[q] = hk + ((first ? 0.f : bf2f(pk4[q])) - hk) * muk[q];
                vb[q] = f2bf(hv + ((first ? 0.f : bf2f(pv4[q])) - hv) * muv[q]);
                wl[q] = -fexp(-fsoftplus(-(w0c[q] + bf2f(aw4[q]))) - 0.5f);
                av[q] = fsigmoid(a0c[q] + bf2f(aa4[q]));
                kk0[q] = kx[q] * kkc[q]; s2 += kk0[q] * kk0[q]; }
            s2 = row_sum16(s2);
            const float rn = __builtin_amdgcn_rsqf(fmaxf(s2, 1e-24f));
            f32x4 kp, nk, bb; float bon = 0.f;
#pragma unroll
            for (int q = 0; q < 4; ++q) { kp[q] = kx[q] * (1.0f + (av[q] - 1.0f) * kac[q]); bon += r[q] * kp[q] * rkc[q]; const float kk = kk0[q] * rn; nk[q] = -kk; bb[q] = kk * av[q]; }
            bon = row_sum16(bon);
            if ((lane & 15) == 0) BON[t * 12 + head] = bon;
            *(f32x4*)(RF + o) = r; *(f32x4*)(LW + o) = wl; *(f32x4*)(KPF + o) = kp; *(f32x4*)(AF + o) = nk; *(f32x4*)(BBF + o) = bb;
            typedef unsigned u32x2_ __attribute__((ext_vector_type(2)));
            *(u32x2_*)(L + RL_VB + tt * RBP + k0 * 2) = (u32x2_){vb[0] | (vb[1] << 16), vb[2] | (vb[3] << 16)};
        }
        if (u + F.G < BATCH * 12 * 128) RW_FETCH(u + F.G);
        lds_barrier();
#pragma unroll
        for (int q = 0; q < 4; ++q) { const int k = (tidl >> 5) * 4 + q, tt = tidl & 31; float c = LW[tt * RFP + k];
            c += __builtin_bit_cast(float, __builtin_amdgcn_update_dpp(0, __builtin_bit_cast(int, c), 0x111, 0xf, 0xf, true));
            c += __builtin_bit_cast(float, __builtin_amdgcn_update_dpp(0, __builtin_bit_cast(int, c), 0x112, 0xf, 0xf, true));
            c += __builtin_bit_cast(float, __builtin_amdgcn_update_dpp(0, __builtin_bit_cast(int, c), 0x114, 0xf, 0xf, true));
            c += __builtin_bit_cast(float, __builtin_amdgcn_update_dpp(0, __builtin_bit_cast(int, c), 0x118, 0xf, 0xf, true));
            c += __builtin_bit_cast(float, __builtin_amdgcn_update_dpp(0, __builtin_bit_cast(int, c), 0x142, 0xa, 0xf, false));
            CUM[tt * RFP + k] = c; if (tt == 31) PC[k] = fexp(c); }
        lds_barrier();
#pragma unroll
        for (int q = 0; q < 4; ++q) { const int i = tidl + 512 * q, tt = i >> 6, k = i & 63, o = tt * RFP + k;
            const float cu = CUM[o], cC = CUM[31 * RFP + k], lwv = LW[o], av = AF[o], rv = RF[o], kv = KPF[o], bv = BBF[o];
            const float en = fexp(-cu), ep = fexp(cu), ec = fexp(cC - cu);
            const float at = av * fexp(cu - lwv), rt = rv * ep, kp = kv * ec;
            AF[o] = at; RF[o] = rt; KPF[o] = kp;
            const int ob = tt * RBP + k * 2;
            *(bf16*)(L + RL_AT + ob) = (bf16)f2bf(at); *(bf16*)(L + RL_RT + ob) = (bf16)f2bf(rt); *(bf16*)(L + RL_BT + ob) = (bf16)f2bf(bv * en);
            *(bf16*)(L + RL_KT + ob) = (bf16)f2bf(kv * en); *(bf16*)(L + RL_BP + ob) = (bf16)f2bf(bv * ec); }
        lds_barrier();
        f32x16 xt;
#pragma unroll
        for (int r = 0; r < 16; ++r) xt[r] = 0.f;
        if (w < 4) {
            const unsigned char* Am = L + ((w == 0 || w == 1) ? RL_BT : RL_KT); const unsigned char* Bm = L + ((w == 1 || w == 3) ? RL_RT : RL_AT);
            f32x16 m;
#pragma unroll
            for (int r = 0; r < 16; ++r) m[r] = 0.f;
#pragma unroll
            for (int kc = 0; kc < 4; ++kc) m = MFMA32(frag_row(Am, RBP, r32, 16 * kc + 8 * hi), frag_row(Bm, RBP, r32, 16 * kc + 8 * hi), m);
#pragma unroll
            for (int r = 0; r < 16; ++r) { const int s = crow(r, hi); const bool keep = (w == 1 || w == 3) ? (s <= r32) : (s < r32); m[r] = keep ? m[r] : 0.f; }
            if (w == 0) {
#pragma unroll
                for (int r = 0; r < 16; ++r) *(bf16*)(L + RL_MP + crow(r, hi) * RMP + r32 * 2) = (bf16)f2bf(m[r]);
            } else if (w == 1) {
#pragma unroll
                for (int r = 0; r < 16; ++r) *(bf16*)(L + RL_MBR + crow(r, hi) * RMP + r32 * 2) = (bf16)f2bf(m[r]);
            } else if (w == 2) {
                xt = m;
            } else {
#pragma unroll
                for (int r = 0; r < 16; ++r) MKR[r * 64 + lane] = m[r];
            }
        }
        if (w < 2) {
#pragma unroll
            for (int rq = 0; rq < 4; ++rq) { const f32x4 y4 = *(const f32x4*)(AF + r32 * RFP + 32 * w + 8 * rq + 4 * hi); xt[4 * rq] = y4[0]; xt[4 * rq + 1] = y4[1]; xt[4 * rq + 2] = y4[2]; xt[4 * rq + 3] = y4[3]; }
        }
        lds_barrier();
#define RW_APPLY(kp) do { unsigned char* xl_ = L + RL_XL + w * (32 * RMP); \
            _Pragma("unroll") for (int r = 0; r < 16; ++r) *(bf16*)(xl_ + crow(r, hi) * RMP + r32 * 2) = (bf16)f2bf(xt[r]); \
            asm volatile("s_waitcnt lgkmcnt(0)" ::: "memory"); \
            _Pragma("unroll") for (int tc = 0; tc < 2; ++tc) xt = MFMA32(frag_row(xl_, RMP, r32, 16 * tc + 8 * hi), frag_col8(L + RL_MP + (kp) * (32 * RMP), RMP, 16 * tc + 8 * hi, 0, lane), xt); } while (0)
        if (w < 3) { RW_APPLY(0); }
        else if (w == 3) {
#pragma unroll 1
            for (int kp = 1; kp < 5; ++kp) { const unsigned char* src = L + RL_MP + (kp - 1) * (32 * RMP); unsigned char* dst = L + RL_MP + kp * (32 * RMP);
                f32x16 m2;
#pragma unroll
                for (int r = 0; r < 16; ++r) m2[r] = 0.f;
#pragma unroll
                for (int tc = 0; tc < 2; ++tc) m2 = MFMA32(frag_row(src, RMP, r32, 16 * tc + 8 * hi), frag_col8(src, RMP, 16 * tc + 8 * hi, 0, lane), m2);
#pragma unroll
                for (int r = 0; r < 16; ++r) *(bf16*)(dst + crow(r, hi) * RMP + r32 * 2) = (bf16)f2bf(m2[r]);
                asm volatile("s_waitcnt lgkmcnt(0)" ::: "memory"); }
        }
        lds_barrier();
        if (w < 3) {
            RW_APPLY(1); RW_APPLY(2); RW_APPLY(3); RW_APPLY(4);
            unsigned char* dst = L + (w < 2 ? RL_W1 + (32 * w) * RMP : RL_W2);
#pragma unroll
            for (int r = 0; r < 16; ++r) *(bf16*)(dst + crow(r, hi) * RMP + r32 * 2) = (bf16)f2bf(xt[r]);
        }
#undef RW_APPLY
        lds_barrier();
#define RW_G4(kpt) do {\
                f32x16 g;\
_Pragma("unroll")\
                for (int r = 0; r < 16; ++r) g[r] = KPF[crow(r, hi) * RFP + 32 * kpt + r32];\
_Pragma("unroll")\
                for (int tc = 0; tc < 2; ++tc) g = MFMA32(frag_row(L + RL_W2, RMP, r32, 16 * tc + 8 * hi), frag_col8(L + RL_BP, RBP, 16 * tc + 8 * hi, 32 * kpt, lane), g);\
                const bf16x8 ga = pack_acc(g, 0), gb = pack_acc(g, 1);\
_Pragma("unroll")\
                for (int vt = 0; vt < 2; ++vt) { f32x16 z;\
_Pragma("unroll")\
                    for (int r = 0; r < 16; ++r) z[r] = 0.f;\
                    z = MFMA32(ga, frag_col44(L + RL_VB, RBP, 4 * hi, 32 * vt, lane), z); z = MFMA32(gb, frag_col44(L + RL_VB, RBP, 16 + 4 * hi, 32 * vt, lane), z);\
                    unsigned* dst = (unsigned*)(F.ws + MX_RSL) + (((size_t)u * 2 + kpt) * 2 + vt) * 512 + lane;\
_Pragma("unroll")\
                    for (int p = 0; p < 8; ++p) dst[p * 64] = cvtpk(z[2 * p], z[2 * p + 1]); }\
        } while (0)
        if (w < 4) {
            const int kt = w >> 1, kpt = w & 1;
            f32x16 g;
#pragma unroll
            for (int r = 0; r < 16; ++r) g[r] = 0.f;
#pragma unroll
            for (int tc = 0; tc < 2; ++tc) g = MFMA32(frag_row(L + RL_W1, RMP, 32 * kt + r32, 16 * tc + 8 * hi), frag_col8(L + RL_BP, RBP, 16 * tc + 8 * hi, 32 * kpt, lane), g);
            if (kt == kpt) { const float pcv = PC[32 * kt + r32];
#pragma unroll
                for (int r = 0; r < 16; ++r) g[r] += (crow(r, hi) == r32) ? pcv : 0.f; }
            unsigned char* dst = F.ws + MX_RA3 + (size_t)u * 8192 + (size_t)((kpt * 2 + kt) * 2) * 1024 + lane * 16;
            *(bf16x8*)dst = pack_acc(g, 0); *(bf16x8*)(dst + 1024) = pack_acc(g, 1);
            if (w == 3) RW_G4(1);
        } else if (w < 6) {
            const int kt = w - 4;
            f32x16 g;
#pragma unroll
            for (int r = 0; r < 16; ++r) g[r] = 0.f;
#pragma unroll
            for (int sc = 0; sc < 2; ++sc) g = MFMA32(frag_row(L + RL_W1, RMP, 32 * kt + r32, 16 * sc + 8 * hi), frag_col8(L + RL_MBR, RMP, 16 * sc + 8 * hi, 0, lane), g);
#pragma unroll
            for (int rq = 0; rq < 4; ++rq) { const f32x4 rv = *(const f32x4*)(RF + r32 * RFP + 32 * kt + 8 * rq + 4 * hi); g[4 * rq] += rv[0]; g[4 * rq + 1] += rv[1]; g[4 * rq + 2] += rv[2]; g[4 * rq + 3] += rv[3]; }
            unsigned char* dst = F.ws + MX_RA1 + (size_t)u * 4096 + (size_t)(kt * 2) * 1024 + lane * 16;
            *(bf16x8*)dst = pack_acc(g, 0); *(bf16x8*)(dst + 1024) = pack_acc(g, 1);
        } else if (w == 6) {
            f32x16 g;
#pragma unroll
            for (int r = 0; r < 16; ++r) g[r] = MKR[r * 64 + lane];
#pragma unroll
            for (int sc = 0; sc < 2; ++sc) g = MFMA32(frag_row(L + RL_W2, RMP, r32, 16 * sc + 8 * hi), frag_col8(L + RL_MBR, RMP, 16 * sc + 8 * hi, 0, lane), g);
            const bf16x8 ga = pack_acc(g, 0), gb = pack_acc(g, 1);
#pragma unroll
            for (int vt = 0; vt < 2; ++vt) { f32x16 z;
#pragma unroll
                for (int r = 0; r < 16; ++r) z[r] = 0.f;
                z = MFMA32(ga, frag_col44(L + RL_VB, RBP, 4 * hi, 32 * vt, lane), z); z = MFMA32(gb, frag_col44(L + RL_VB, RBP, 16 + 4 * hi, 32 * vt, lane), z);
                unsigned* dst = (unsigned*)(F.ws + MX_ROL) + ((size_t)u * 2 + vt) * 512 + lane;
#pragma unroll
                for (int p = 0; p < 8; ++p) dst[p * 64] = cvtpk(z[2 * p], z[2 * p + 1]); }
        } else {
            RW_G4(0);
        }
    }
#undef RW_G4
#undef RW_FETCH
}
DI void phase_rwkv_seq(Frame& F) {
    enter(F);
    float* RO = (float*)(F.ws + MX_RO);
    const int lane = F.lane, r32 = lane & 31, hi = lane >> 5, vt = F.wave;
    if (F.bid < BATCH * 12 && vt < 2) {
        const int b = F.bid / 12, head = F.bid % 12;
        f32x16 X[2];
#pragma unroll
        for (int kt = 0; kt < 2; ++kt)
#pragma unroll
            for (int r = 0; r < 16; ++r) X[kt][r] = 0.f;
        bf16x8 n3[8], n1[4]; unsigned nol[8], nsl[2][8];
#define RS_FETCH(nn) do { const size_t u_ = (size_t)F.bid * 128 + (nn); \
            const unsigned char* a3p = F.ws + MX_RA3 + u_ * 8192 + lane * 16; const unsigned char* a1p = F.ws + MX_RA1 + u_ * 4096 + lane * 16; \
            const unsigned* olp = (const unsigned*)(F.ws + MX_ROL) + (u_ * 2 + vt) * 512 + lane; const unsigned* slp = (const unsigned*)(F.ws + MX_RSL) + (u_ * 4 + vt) * 512 + lane; \
            _Pragma("unroll") for (int f = 0; f < 8; ++f) n3[f] = *(const bf16x8*)(a3p + f * 1024); \
            _Pragma("unroll") for (int f = 0; f < 4; ++f) n1[f] = *(const bf16x8*)(a1p + f * 1024); \
            _Pragma("unroll") for (int p = 0; p < 8; ++p) { nol[p] = olp[p * 64]; nsl[0][p] = slp[p * 64]; nsl[1][p] = slp[1024 + p * 64]; } } while (0)
        RS_FETCH(0);
#pragma unroll 1
        for (int n = 0; n < 128; ++n) {
            bf16x8 a3[8], a1[4]; unsigned ol[8], sl[2][8];
#pragma unroll
            for (int f = 0; f < 8; ++f) a3[f] = n3[f];
#pragma unroll
            for (int f = 0; f < 4; ++f) a1[f] = n1[f];
#pragma unroll
            for (int p = 0; p < 8; ++p) { ol[p] = nol[p]; sl[0][p] = nsl[0][p]; sl[1][p] = nsl[1][p]; }
            if (n + 1 < 128) RS_FETCH(n + 1);
            bf16x8 Xp[2][2];
#pragma unroll
            for (int kt = 0; kt < 2; ++kt) { Xp[kt][0] = pack_acc(X[kt], 0); Xp[kt][1] = pack_acc(X[kt], 1); }
            f32x16 O;
#pragma unroll
            for (int p = 0; p < 8; ++p) { O[2 * p] = __builtin_bit_cast(float, ol[p] << 16); O[2 * p + 1] = __builtin_bit_cast(float, ol[p] & 0xffff0000u); }
#pragma unroll
            for (int kt = 0; kt < 2; ++kt)
#pragma unroll
                for (int s = 0; s < 2; ++s) O = MFMA32(a1[kt * 2 + s], Xp[kt][s], O);
            float* op = RO + ((size_t)b * SEQ + 32 * n + 4 * hi) * TOKW + head * 64 + 32 * vt + r32;
#pragma unroll
            for (int r = 0; r < 16; ++r) op[(size_t)((r & 3) + 8 * (r >> 2)) * TOKW] = O[r];
#pragma unroll
            for (int kpt = 0; kpt < 2; ++kpt) { f32x16 Xn;
#pragma unroll
                for (int p = 0; p < 8; ++p) { Xn[2 * p] = __builtin_bit_cast(float, sl[kpt][p] << 16); Xn[2 * p + 1] = __builtin_bit_cast(float, sl[kpt][p] & 0xffff0000u); }
#pragma unroll
                for (int kt = 0; kt < 2; ++kt)
#pragma unroll
                    for (int s = 0; s < 2; ++s) Xn = MFMA32(a3[(kpt * 2 + kt) * 2 + s], Xp[kt][s], Xn);
                X[kpt] = Xn; }
        }
    }
#undef RS_FETCH
}

DI void phase_nsa_cmp2(Frame& F, int j, bool own) {
    enter(F);
    const bf16* CH = (const bf16*)(F.ws + MX_CMPH); const bf16* W2T = (const bf16*)(F.ws + WS_CW2T) + (size_t)j * 2 * 64 * 256;
    const int lane = F.lane, r32 = lane & 31, hi = lane >> 5;
    const int gw = F.bid * 8 + F.wave, NGW = F.G * 8;
    for (int u = own ? (F.bid < 64 ? F.bid * 8 + F.wave : 2 * 256) : gw; u < 2 * 256; u += own ? 2 * 256 : NGW) {
        const int which = u >> 8, rt = u & 255;
        const bf16* ap = CH + ((size_t)which * 8192 + rt * 32 + r32) * 256 + 8 * hi; const bf16* bp = W2T + ((size_t)which * 64 + r32) * 256 + 8 * hi;
        f32x16 o0, o1;
#pragma unroll
        for (int r = 0; r < 16; ++r) { o0[r] = 0.f; o1[r] = 0.f; }
#pragma unroll
        for (int ks = 0; ks < 16; ++ks) { const bf16x8 af = *(const bf16x8*)(ap + 16 * ks);
            o0 = MFMA32(af, *(const bf16x8*)(bp + 16 * ks), o0); o1 = MFMA32(af, *(const bf16x8*)(bp + 32 * 256 + 16 * ks), o1); }
        bf16* dst = (bf16*)(F.ws + (which ? MX_VCB : MX_KCB));
#pragma unroll
        for (int r = 0; r < 16; ++r) { const int row = rt * 32 + crow(r, hi);
            if (row < BATCH * NC * 4) { const int g = row & 3, bn = row >> 2, b = bn / NC, n = bn % NC; bf16* p = dst + ((size_t)(b * 4 + g) * 256 + n) * 64;
                p[r32] = (bf16)f2bf(o0[r]); p[32 + r32] = (bf16)f2bf(o1[r]); } }
    }
    for (int blk = F.bid; blk < 2 * BATCH * 4 * 64 / 512; blk += F.G) { const int i = blk * 512 + F.tid; const int which = i >> 11, bg = (i >> 6) & 31, dd = i & 63;
        ((bf16*)(F.ws + (which ? MX_VCB : MX_KCB)))[((size_t)bg * 256 + 255) * 64 + dd] = 0; }
}

DI void cmp_scores(f32x16& p0, f32x16& p1, const unsigned char* Kl, const bf16x8 (&qf)[4], int lane, int kt, int tqm, int tqm0, const float* btab) {
    const int r32 = lane & 31, hi = lane >> 5;
#pragma unroll
    for (int i = 0; i < 16; ++i) { p0[i] = 0.f; p1[i] = 0.f; }
    const unsigned char* kb = Kl + kt * KVTILE + r32 * KVP + hi * 16;
#pragma unroll
    for (int dc = 0; dc < 4; ++dc) {
        const bf16x8 k0 = *(const bf16x8*)(kb + dc * 32), k1 = *(const bf16x8*)(kb + 32 * KVP + dc * 32);
        p0 = MFMA32(k0, qf[dc], p0); p1 = MFMA32(k1, qf[dc], p1);
    }
    if (tqm0 - 16 * (64 * kt + 63) >= 128) { const float cf = btab[191];
#pragma unroll
        for (int r = 0; r < 16; ++r) { p0[r] = p0[r] * LOG2E + cf; p1[r] = p1[r] * LOG2E + cf; }
        return; }
    int db = tqm - 16 * (64 * kt + 4 * hi); asm volatile("" : "+v"(db));
#pragma unroll
    for (int r = 0; r < 16; ++r) {
        const int d0 = db - 16 * ((r & 3) + 8 * (r >> 2)), d1 = d0 - 512;
        const float b0 = btab[d0 < 0 ? 0 : (d0 > 191 ? 191 : d0)], b1 = btab[d1 < 0 ? 0 : (d1 > 191 ? 191 : d1)];
        p0[r] = d0 >= 0 ? p0[r] * LOG2E + b0 : -1e30f;
        p1[r] = d1 >= 0 ? p1[r] * LOG2E + b1 : -1e30f;
    }
}
DI void phase_nsa_cmpattn_mfma(const Args& a, Frame& F) {
    enter(F);
    const bf16* HB = (const bf16*)(F.ws + WS_HB); const bf16* KCB = (const bf16*)(F.ws + MX_KCB); const bf16* VCB = (const bf16*)(F.ws + MX_VCB);
    float* OC = (float*)(F.ws + MX_OC); unsigned long long* SELM = (unsigned long long*)(F.ws + MX_SELM);
    const float* rel = a.in[I_REL];
    unsigned char* Kl = F.lds; unsigned char* Vl = F.lds + 4 * KVTILE; float* btab = (float*)(F.lds + 8 * KVTILE);
    const int lane = F.lane, r32 = lane & 31, hi = lane >> 5;
    for (int u = F.bid; u < BATCH * 4 * 16; u += F.G) {
        const int b = u >> 6, g = (u >> 4) & 3, qt = ((u >> 8) & 1) ? 15 - (u & 15) : (u & 15);
        lds_barrier();
#pragma unroll
        for (int kt = 0; kt < 4; ++kt) { KVRegs R; const size_t off = ((size_t)(b * 4 + g) * 256 + kt * 64) * 64; kv_load(R, KCB + off, VCB + off, 64, F.tid); kv_store(R, Kl + kt * KVTILE, Vl + kt * KVTILE, F.tid); }
        { int tl = F.tid; asm volatile("" : "+v"(tl)); for (int i = tl; i < 576; i += 512) { const int r = i / 192, dd = i % 192; btab[i] = rel[t5_bucket(dd) * 12 + g * 3 + r] * LOG2E; } }
        lds_barrier();
        const int tq = qt * 256 + F.wave * 32 + r32, t = b * SEQ + tq, tqm = tq - 31;
        const int tqm0 = __builtin_amdgcn_readfirstlane(qt * 256 + F.wave * 32 - 31);
        const int ntile = (__builtin_amdgcn_readfirstlane(qt * 256 + F.wave * 32 + 31 - 31) / 16) / 64 + 1;
        float self[32];
#pragma unroll
        for (int i = 0; i < 32; ++i) self[i] = 0.f;
#pragma unroll 1
        for (int r = 0; r < 3; ++r) {
            const int hh = g * 3 + r;
            bf16x8 qf[4]; load_q(qf, HB + (size_t)t * HC + NQ + hh * 64, hi);
            const float* bt = btab + r * 192;
            float m = -1e30f, l = 0.f, carry = 0.f;
            f32x16 o0, o1; float imp[32];
#pragma unroll
            for (int i = 0; i < 16; ++i) { o0[i] = 0.f; o1[i] = 0.f; }
#pragma unroll
            for (int i = 0; i < 32; ++i) imp[i] = 0.f;
#pragma unroll 1
            for (int kt = 0; kt < ntile; ++kt) {
                f32x16 p0, p1; cmp_scores(p0, p1, Kl, qf, lane, kt, tqm, tqm0, bt);
                float mx = fmaxf(p0[0], p1[0]);
#pragma unroll
                for (int i = 1; i < 16; ++i) mx = fmaxf(mx, fmaxf(p0[i], p1[i]));
                mx = xmax_half(mx);
                const float mn = fmaxf(m, mx);
                if (__any(mn > m)) { const float alpha = __builtin_amdgcn_exp2f(m - mn); l *= alpha; carry *= alpha;
#pragma unroll
                    for (int i = 0; i < 16; ++i) { o0[i] *= alpha; o1[i] *= alpha; }
#pragma unroll
                    for (int i = 0; i < 32; ++i) imp[i] *= alpha;
                    m = mn; }
                float rs = 0.f;
#pragma unroll
                for (int i = 0; i < 16; ++i) { p0[i] = (p0[i] > -1e29f) ? __builtin_amdgcn_exp2f(p0[i] - m) : 0.f; p1[i] = (p1[i] > -1e29f) ? __builtin_amdgcn_exp2f(p1[i] - m) : 0.f; rs += p0[i] + p1[i]; }
                l += rs;
                float qs[8], ql[8];
#pragma unroll
                for (int q4 = 0; q4 < 4; ++q4) {
                    qs[q4] = (p0[4 * q4] + p0[4 * q4 + 1]) + (p0[4 * q4 + 2] + p0[4 * q4 + 3]); ql[q4] = p0[4 * q4 + 3];
                    qs[4 + q4] = (p1[4 * q4] + p1[4 * q4 + 1]) + (p1[4 * q4 + 2] + p1[4 * q4 + 3]); ql[4 + q4] = p1[4 * q4 + 3];
                }
                float xl[8];
#pragma unroll
                for (int e = 0; e < 8; ++e) xl[e] = xhalf(ql[e]);
#pragma unroll
                for (int e = 0; e < 8; ++e) qs[e] += hi ? xl[e] : (e > 0 ? xl[e - 1] : carry);
                carry = xl[7];
#pragma unroll
                for (int k2 = 0; k2 < 4; ++k2) if (kt == k2) {
#pragma unroll
                    for (int e = 0; e < 8; ++e) imp[8 * k2 + e] += qs[e]; }
                const bf16x8 pa0 = pack_acc(p0, 0), pa1 = pack_acc(p0, 1), pa2 = pack_acc(p1, 0), pa3 = pack_acc(p1, 1);
                const unsigned char* Vt = Vl + kt * KVTILE;
                o0 = MFMA32(frag_col44(Vt, KVP, 4 * hi, 0, lane), pa0, o0);       o1 = MFMA32(frag_col44(Vt, KVP, 4 * hi, 32, lane), pa0, o1);
                o0 = MFMA32(frag_col44(Vt, KVP, 16 + 4 * hi, 0, lane), pa1, o0);  o1 = MFMA32(frag_col44(Vt, KVP, 16 + 4 * hi, 32, lane), pa1, o1);
                o0 = MFMA32(frag_col44(Vt, KVP, 32 + 4 * hi, 0, lane), pa2, o0);  o1 = MFMA32(frag_col44(Vt, KVP, 32 + 4 * hi, 32, lane), pa2, o1);
                o0 = MFMA32(frag_col44(Vt, KVP, 48 + 4 * hi, 0, lane), pa3, o0);  o1 = MFMA32(frag_col44(Vt, KVP, 48 + 4 * hi, 32, lane), pa3, o1);
            }
            l = xsum_half(l);
            const float inv = 1.0f / fmaxf(l, 1e-30f);
#pragma unroll
            for (int i = 0; i < 16; ++i) { o0[i] *= inv; o1[i] *= inv; }
#pragma unroll
            for (int i = 0; i < 32; ++i) self[i] += imp[i] * inv;
            float* op = OC + (size_t)t * TOKW + hh * 64;
#pragma unroll
            for (int rq = 0; rq < 4; ++rq) { *(f32x4*)(op + 8 * rq + 4 * hi) = (f32x4){o0[4 * rq], o0[4 * rq + 1], o0[4 * rq + 2], o0[4 * rq + 3]};
                *(f32x4*)(op + 32 + 8 * rq + 4 * hi) = (f32x4){o1[4 * rq], o1[4 * rq + 1], o1[4 * rq + 2], o1[4 * rq + 3]}; }
        }
        const int cur = tq >> 6;
        float sc[32];
#pragma unroll
        for (int i = 0; i < 32; ++i) {
            const float imp = self[i];
            const int mblk = 2 * i + hi;
            const bool forced = (mblk == 0) || (mblk == cur) || (mblk == cur - 1);
            sc[i] = mblk <= cur ? (forced ? 1.0e4f : imp) : -1.0f;
        }
        unsigned wlo = 0u, whi = 0u;
#pragma unroll 1
        for (int round = 0; round < 16; ++round) {
            float bv = sc[0]; int bi = 0;
#pragma unroll
            for (int i = 1; i < 32; ++i) { const bool gt = sc[i] > bv; bv = gt ? sc[i] : bv; bi = gt ? i : bi; }
            const int gm = 2 * bi + hi;
            const float pv = xhalf(bv); const int pm = __shfl_xor(gm, 32);
            const bool win = (bv > pv) || (bv == pv && gm < pm);
            if (win && bv >= 0.f) { if (gm < 32) wlo |= 1u << gm; else whi |= 1u << (gm - 32); }
#pragma unroll
            for (int i = 0; i < 32; ++i) sc[i] = (win && i == bi) ? -2.0f : sc[i];
        }
        wlo |= (unsigned)__shfl_xor((int)wlo, 32); whi |= (unsigned)__shfl_xor((int)whi, 32);
        if (hi == 0) SELM[(size_t)t * 4 + g] = ((unsigned long long)whi << 32) | wlo;
    }
}

DI void ln_wave(f32x4 (&v)[4], const float* g, const float* b, int lane) {
    float s = 0.f;
#pragma unroll
    for (int j = 0; j < 4; ++j) s += (v[j][0] + v[j][1]) + (v[j][2] + v[j][3]);
    const float mean = wave_sum(s) * (1.0f / D); float s2 = 0.f;
#pragma unroll
    for (int j = 0; j < 4; ++j) { v[j] = v[j] - mean; s2 += (v[j][0] * v[j][0] + v[j][1] * v[j][1]) + (v[j][2] * v[j][2] + v[j][3] * v[j][3]); }
    const float rstd = 1.0f / sqrtf(wave_sum(s2) * opq(1.0f / D) + opq(LN_EPS));
#pragma unroll
    for (int j = 0; j < 4; ++j) { const f32x4 gv = ((const f32x4*)g)[lane + 64 * j], bv = ((const f32x4*)b)[lane + 64 * j]; v[j] = v[j] * rstd * gv + bv; }
}
DI void phase_moe_route(const Args& a, Frame& F, int L) {
    enter(F);
    const bf16* Z = (const bf16*)(F.ws + WS_Z); bf16* X1B = (bf16*)(F.ws + WS_X1B);
    int* TOKE = (int*)(F.ws + WS_TOKE); float* TOKG = (float*)(F.ws + WS_TOKG); int* TOKL = (int*)(F.ws + WS_TOKL);
    unsigned* gcnt = (unsigned*)(F.ws + WS_CTL) + CW_CNT + 64 * L;
    const float* g1 = a.in[I_LN1G] + (size_t)L * D, *b1 = a.in[I_LN1B] + (size_t)L * D;
    const float* rw = a.in[I_RTW] + (size_t)L * D * NE, *rb = a.in[I_RTB] + (size_t)L * NE;
    constexpr int XP = 1028;
    float* xs = (float*)F.lds;
    float* part = (float*)(F.lds + 65792);
    constexpr int RCAP = 8;
    int* lrank = (int*)(F.lds + 65792 + 16384);
    int* lexp = lrank + RCAP * 64;
    int* hist = (int*)(F.lds + MISC_OFF + MS_HIST); int* base = (int*)(F.lds + MISC_OFF + MS_BASE);
    const int lane = F.lane, wv = F.wave;
    { int* RTK = (int*)(F.ws + WS_ROWTOK); for (int blk = F.bid; blk < MOEROWS / 512; blk += F.G) RTK[blk * 512 + F.tid] = 0; }
    float bw[32][2];
#pragma unroll
    for (int ks = 0; ks < 32; ++ks)
#pragma unroll
        for (int eh = 0; eh < 2; ++eh) bw[ks][eh] = rw[(size_t)(128 * wv + 4 * ks + (lane >> 4)) * NE + 16 * eh + (lane & 15)];
    v2u zn[2][4];
    if (F.bid < T / 16) {
#pragma unroll
        for (int rr = 0; rr < 2; ++rr)
#pragma unroll
            for (int j = 0; j < 4; ++j) zn[rr][j] = ((const v2u*)(Z + (size_t)(F.bid * 16 + wv * 2 + rr) * D))[lane + 64 * j]; }
    if (F.tid < 32) hist[F.tid] = 0;
    int kq = 0, kb = 0;
    for (int tile = F.bid; tile < T / 16; tile += F.G) {
        const int t0 = tile * 16;
        lds_barrier();
#pragma unroll
        for (int rr = 0; rr < 2; ++rr) { const int tk = wv * 2 + rr, t = t0 + tk;
            f32x4 v[4];
#pragma unroll
            for (int j = 0; j < 4; ++j) { const v2u z = zn[rr][j]; v[j] = (f32x4){__builtin_bit_cast(float, z.x << 16), __builtin_bit_cast(float, z.x & 0xffff0000u), __builtin_bit_cast(float, z.y << 16), __builtin_bit_cast(float, z.y & 0xffff0000u)}; }
            ln_wave(v, g1, b1, lane);
#pragma unroll
            for (int j = 0; j < 4; ++j) { *(f32x4*)(xs + tk * XP + 4 * (lane + 64 * j)) = v[j];
                v2u o; o.x = pk2(v[j][0], v[j][1]); o.y = pk2(v[j][2], v[j][3]); ((v2u*)(X1B + (size_t)t * D))[lane + 64 * j] = o; } }
        if (tile + F.G < T / 16) {
#pragma unroll
            for (int rr = 0; rr < 2; ++rr)
#pragma unroll
                for (int j = 0; j < 4; ++j) zn[rr][j] = ((const v2u*)(Z + (size_t)((tile + F.G) * 16 + wv * 2 + rr) * D))[lane + 64 * j]; }
        lds_barrier();
        {
            f32x4 c0 = {0.f, 0.f, 0.f, 0.f}, c1 = {0.f, 0.f, 0.f, 0.f};
            const float* ap = xs + (lane & 15) * XP + 128 * wv + (lane >> 4);
#pragma unroll
            for (int ks = 0; ks < 32; ++ks) { const float av = ap[4 * ks];
                c0 = __builtin_amdgcn_mfma_f32_16x16x4f32(av, bw[ks][0], c0, 0, 0, 0); c1 = __builtin_amdgcn_mfma_f32_16x16x4f32(av, bw[ks][1], c1, 0, 0, 0); }
#pragma unroll
            for (int r = 0; r < 4; ++r) { const int tok = (lane >> 4) * 4 + r; part[(wv * 16 + tok) * 32 + (lane & 15)] = c0[r]; part[(wv * 16 + tok) * 32 + 16 + (lane & 15)] = c1[r]; }
        }
        lds_barrier();
        const int tk = F.tid >> 5, e = F.tid & 31, t = t0 + tk;
        float lg = rb[e];
#pragma unroll
        for (int w8 = 0; w8 < 8; ++w8) lg += part[(w8 * 16 + tk) * 32 + e];
        float tv[4]; int ti[4];
        { float* lgl = (float*)(F.lds + 86272); float* tvs = (float*)(F.lds + 88320); unsigned* tis = (unsigned*)(F.lds + 88576);
          lgl[tk * 32 + e] = lg;
          int rank = 0;
#pragma unroll
          for (int k4 = 0; k4 < 8; ++k4) { const f32x4 v = *(const f32x4*)(lgl + tk * 32 + 4 * k4);
#pragma unroll
              for (int d = 0; d < 4; ++d) { const int k = 4 * k4 + d; rank += (v[d] > lg || (v[d] == lg && k < e)) ? 1 : 0; } }
          if (rank < 4) { tvs[tk * 4 + rank] = lg; tis[tk * 4 + rank] = (unsigned)e; }
          const f32x4 tv4 = *(const f32x4*)(tvs + tk * 4); const v4u ti4 = *(const v4u*)(tis + tk * 4);
          tv[0] = tv4[0]; tv[1] = tv4[1]; tv[2] = tv4[2]; tv[3] = tv4[3]; ti[0] = (int)ti4.x; ti[1] = (int)ti4.y; ti[2] = (int)ti4.z; ti[3] = (int)ti4.w; }
        const float e0 = 1.0f, e1 = expf(tv[1] - tv[0]), e2 = expf(tv[2] - tv[0]), e3 = expf(tv[3] - tv[0]);
        const float inv = 1.0f / (e0 + e1 + e2 + e3);
        if (e < 4) { const int myi = e == 0 ? ti[0] : e == 1 ? ti[1] : e == 2 ? ti[2] : ti[3]; const float myg = (e == 0 ? e0 : e == 1 ? e1 : e == 2 ? e2 : e3) * inv;
            TOKE[(size_t)t * 4 + e] = myi; TOKG[(size_t)t * 4 + e] = myg;
            lrank[kq * 64 + tk * 4 + e] = atomicAdd(&hist[myi], 1); lexp[kq * 64 + tk * 4 + e] = myi; }
        ++kq;
        if (kq == RCAP || tile + F.G >= T / 16) {
            lds_barrier();
            if (F.tid < 32) { base[F.tid] = (int)atomicAdd(&gcnt[F.tid], (unsigned)hist[F.tid]); hist[F.tid] = 0; }
            lds_barrier();
            for (int i = F.tid; i < kq * 64; i += 512) { const int jt = i >> 6, r = i & 63; const size_t tok0 = (size_t)(F.bid + (kb + jt) * F.G) * 16;
                TOKL[tok0 * 4 + r] = base[lexp[i]] + lrank[i]; }
            kb += kq; kq = 0;
        }
    }
}
DI void moe_tables(Frame& F, int L) {
    enter(F);
    const unsigned* gcnt = (const unsigned*)(F.ws + WS_CTL) + CW_CNT + 64 * L;
    int* pads = (int*)(F.lds + MISC_OFF + MS_PADS); int* nbp = (int*)(F.lds + MISC_OFF + MS_NB); unsigned char* bexp = F.lds + MISC_OFF + MS_BEXP;
    __syncthreads();
    if (F.tid < 64) {
        const int e = F.tid, c = e < NE ? (int)__hip_atomic_load(&gcnt[e], __ATOMIC_RELAXED, __HIP_MEMORY_SCOPE_AGENT) : 0, p = (c + 255) / 256 * 256;
        int sfx = p;
#pragma unroll
        for (int o = 1; o < 32; o <<= 1) { const int up = __shfl_up(sfx, o, 32); if ((e & 31) >= o) sfx += up; }
        if (e < NE) pads[e] = sfx - p;
        if (e == NE - 1) { pads[NE] = sfx; nbp[0] = sfx / 256; } }
    __syncthreads();
    for (int bI = F.tid; bI < NBMAX; bI += 512) { const int row = bI * 256;
        int ee = 0; for (int k = 0; k < NE; ++k) if (pads[k] <= row && pads[k + 1] > row) ee = k;
        bexp[bI] = (unsigned char)ee; }
    __syncthreads();
}
DI void phase_moe_gather(Frame& F, int L) {
    moe_tables(F, L);
    const int* pads = (const int*)(F.lds + MISC_OFF + MS_PADS);
    const int* TOKE = (const int*)(F.ws + WS_TOKE); const int* TOKL = (const int*)(F.ws + WS_TOKL); int* TOKS = (int*)(F.ws + WS_TOKS); int* RTK = (int*)(F.ws + WS_ROWTOK);
    for (int blk = F.bid; blk < T * 4 / 512; blk += F.G) { const int i = blk * 512 + F.tid; const int slot = pads[TOKE[i]] + TOKL[i]; TOKS[i] = slot; RTK[slot] = i >> 2; }
}
DI void moe_rowtab(Frame& F, int nN) {
    const int NB = *(const int*)(F.lds + MISC_OFF + MS_NB); const int* RTK = (const int*)(F.ws + WS_ROWTOK);
    unsigned short* rt = (unsigned short*)(F.lds + MISC_OFF + MS_RT);
    int tok[17];
#pragma unroll
    for (int i = 0; i < 17; ++i) { const int x = F.bid & 7, q = i * (F.G >> 3) + (F.bid >> 3), chunk = (NB + 7) >> 3, r = q / nN, pm = x * chunk + r;
        tok[i] = (r < chunk && pm < NB && F.tid < 256) ? RTK[pm * 256 + F.tid] : -1; }
#pragma unroll
    for (int i = 0; i < 17; ++i) if (tok[i] >= 0) rt[i * 256 + F.tid] = (unsigned short)tok[i];
    __syncthreads();
}
DI void phase_moe_combine(const Args& a, Frame& F, int L) {
    enter(F);
    const bf16* Y = (const bf16*)(F.ws + WS_Y); const bf16* X1B = (const bf16*)(F.ws + WS_X1B);
    const int* TOKS = (const int*)(F.ws + WS_TOKS); const float* TOKG = (const float*)(F.ws + WS_TOKG);
    bf16* XB = (bf16*)(F.ws + WS_XB);
    const float* g2 = a.in[I_LN2G] + (size_t)L * D, *b2 = a.in[I_LN2B] + (size_t)L * D;
    const int gw = F.bid * 8 + F.wave, NGW = F.G * 8;
    for (int t0 = gw * 2; t0 < T; t0 += NGW * 2) {
        int slot[2][4]; float gt[2][4];
#pragma unroll
        for (int q = 0; q < 2; ++q)
#pragma unroll
            for (int k = 0; k < 4; ++k) { slot[q][k] = TOKS[(size_t)(t0 + q) * 4 + k]; gt[q][k] = TOKG[(size_t)(t0 + q) * 4 + k]; }
        v4u xr[2][2], yr[2][4][2];
#pragma unroll
        for (int q = 0; q < 2; ++q) {
            xr[q][0] = ((const v4u*)(X1B + (size_t)(t0 + q) * D))[F.lane]; xr[q][1] = ((const v4u*)(X1B + (size_t)(t0 + q) * D))[F.lane + 64];
#pragma unroll
            for (int k = 0; k < 4; ++k) { yr[q][k][0] = ((const v4u*)(Y + (size_t)slot[q][k] * D))[F.lane]; yr[q][k][1] = ((const v4u*)(Y + (size_t)slot[q][k] * D))[F.lane + 64]; } }
#pragma unroll
        for (int q = 0; q < 2; ++q) {
            const int t = t0 + q;
            float v[16];
#pragma unroll
            for (int h = 0; h < 2; ++h)
#pragma unroll
                for (int e = 0; e < 4; ++e) { const unsigned wv = xr[q][h][e]; v[8 * h + 2 * e] = __builtin_bit_cast(float, wv << 16) * DEEP_ALPHA; v[8 * h + 2 * e + 1] = __builtin_bit_cast(float, wv & 0xffff0000u) * DEEP_ALPHA; }
#pragma unroll
            for (int k = 0; k < 4; ++k)
#pragma unroll
                for (int h = 0; h < 2; ++h)
#pragma unroll
                    for (int e = 0; e < 4; ++e) { const unsigned wv = yr[q][k][h][e]; v[8 * h + 2 * e] += __builtin_bit_cast(float, wv << 16) * gt[q][k]; v[8 * h + 2 * e + 1] += __builtin_bit_cast(float, wv & 0xffff0000u) * gt[q][k]; }
            float s = 0.f;
#pragma unroll
            for (int i = 0; i < 16; ++i) s += v[i];
            const float mean = wave_sum(s) * (1.0f / D); float s2 = 0.f;
#pragma unroll
            for (int i = 0; i < 16; ++i) { v[i] -= mean; s2 += v[i] * v[i]; }
            const float rstd = 1.0f / sqrtf(wave_sum(s2) * opq(1.0f / D) + opq(LN_EPS));
#pragma unroll
            for (int h = 0; h < 2; ++h) {
                const int c0 = 512 * h + 8 * F.lane;
                const f32x4 ga = *(const f32x4*)(g2 + c0), gb = *(const f32x4*)(g2 + c0 + 4), ba = *(const f32x4*)(b2 + c0), bb = *(const f32x4*)(b2 + c0 + 4);
                float o[8];
#pragma unroll
                for (int e = 0; e < 4; ++e) { o[e] = v[8 * h + e] * rstd * ga[e] + ba[e]; o[4 + e] = v[8 * h + 4 + e] * rstd * gb[e] + bb[e]; }
                if (L == DEPTH - 1) { *(f32x4*)(a.out + (size_t)t * D + c0) = (f32x4){o[0], o[1], o[2], o[3]}; *(f32x4*)(a.out + (size_t)t * D + c0 + 4) = (f32x4){o[4], o[5], o[6], o[7]}; }
                v4u w; w.x = pk2(o[0], o[1]); w.y = pk2(o[2], o[3]); w.z = pk2(o[4], o[5]); w.w = pk2(o[6], o[7]);
                *(v4u*)(XB + (size_t)t * D + c0) = w;
            }
        }
    }
}

DI bool in_range(int k, int lo, int hi) { asm volatile("" : "+s"(lo), "+s"(hi)); return lo <= k && k < hi; }
constexpr int PH_PER_LAYER = 12, NPHASES = 1 + DEPTH * PH_PER_LAYER;
__global__ void __launch_bounds__(512, 2) fwd(Args a) {
    extern __shared__ __attribute__((aligned(16))) unsigned char lds[];
    Frame F;
    F.lds = lds; F.ws = a.ws; F.tid = threadIdx.x; F.lane = F.tid & 63; F.wave = __builtin_amdgcn_readfirstlane(F.tid >> 6); F.G = gridDim.x; F.bid = blockIdx.x;
    if (F.tid < 4) ((unsigned*)(lds + MISC_OFF + MS_BAR))[F.tid] = 0u;
    __syncthreads();
    const int lo = a.ph_lo, hi = a.ph_hi;
    const bool multi = (hi - lo) > 1;
    XcdBarrier bar; bar.bar = (unsigned*)(a.ws + WS_CTL) + CW_BAR; bar.x = 0; bar.st = (volatile LAS unsigned*)(LAS unsigned char*)(lds + MISC_OFF + MS_BAR); bar.wave = F.wave;
    if (multi) { bar = xcd_barrier_post((unsigned*)(a.ws + WS_CTL) + CW_BAR, (volatile LAS unsigned*)(LAS unsigned char*)(lds + MISC_OFF + MS_BAR)); bar.wave = F.wave; }
#define IN(k) in_range((k), lo, hi)
#define SEAM(k) do { if (IN((k) + 1)) xcd_barrier(bar); } while (0)
#define REP(bit) for (int rep_ = 0; rep_ <= ((a.probe >> (bit)) & 1); ++rep_)
    PG8_LAS unsigned char* ring = (PG8_LAS unsigned char*)lds;

    if (IN(0)) { REP(0) phase_prologue(a, F); SEAM(0); }
    for (int L = 0; L < DEPTH; ++L) {
        const int kind = L % 3, j = L / 3, p0 = 1 + L * PH_PER_LAYER;
        if (hi <= p0 || lo >= p0 + PH_PER_LAYER) continue;
        const int mq = kind == 0 ? NMQ : kind == 1 ? GMQ : RMQ;
        if (IN(p0)) { REP(1) {
            { enter(F); pg8::SchedDense S; S.init(a.ws + WS_XB, a.ws + WS_WIN + (size_t)L * WIN_STRIDE, T, HC, D, F.G, F.bid);
              pg8::EpiBf16P E{(bf16*)(a.ws + WS_HB), HC}; pg8::gemm_phase<pg8::EpiBf16P, pg8::SchedDense, true, true>(ring, D, S, E, F.wave); }
            { enter(F); pg8::SchedDense S; S.init(a.ws + WS_MEMB, a.ws + WS_WKV + (size_t)L * 512 * D * 2, BATCH * MEMLEN, 512, D, F.G, F.G - 1 - F.bid);
              pg8::EpiBf16P E{(bf16*)(a.ws + WS_KVB), 512}; pg8::gemm_phase<pg8::EpiBf16P, pg8::SchedDense, true, true>(ring, D, S, E, F.wave); } }
            SEAM(p0);
        }
        if (kind == 0) {
            if (IN(p0 + 1)) { REP(2) phase_nsa_cmpA(a, F, j); SEAM(p0 + 1); }
            if (IN(p0 + 2)) { REP(2) { enter(F); pg8::SchedPair S{(const char*)(a.ws + MX_CMPA), (const char*)(a.ws + WS_CW1 + (size_t)j * 2 * 256 * 2048 * 2), (size_t)8192 * 2048 * 2, (size_t)256 * 2048 * 2, 2048, 32, 1, F.G, F.bid};
                pg8::EpiBf16Gelu E{(bf16*)(a.ws + MX_CMPH), 256, (size_t)8192 * 256}; pg8::gemm_phase<pg8::EpiBf16Gelu, pg8::SchedPair, true, true>(ring, 2048, S, E, F.wave);
                  asm volatile("s_waitcnt vmcnt(0)" ::: "memory"); __syncthreads();
                  phase_nsa_cmp2(F, j, true); }
                REP(9) phase_memattn_mfma(F, mq, 64);
                SEAM(p0 + 2); }
            if (IN(p0 + 4)) { REP(3) phase_nsa_cmpattn_mfma(a, F); SEAM(p0 + 4); }
            if (IN(p0 + 5)) { REP(4) phase_nsa_selwin_mfma(a, F, j); SEAM(p0 + 5); }
        } else if (kind == 1) {
            if (IN(p0 + 1)) { REP(5) phase_gla_prep(a, F); SEAM(p0 + 1); }
            if (IN(p0 + 2)) { REP(16) phase_gla_seq(F); REP(15) phase_gla_intra(F, BATCH * 4); REP(9) phase_memattn_mfma(F, mq, BATCH * 4); SEAM(p0 + 2); }
            if (IN(p0 + 4)) { REP(19) phase_gla_out2(a, F); SEAM(p0 + 4); }
        } else {
            if (IN(p0 + 1)) { REP(7) phase_rwkv_lo(a, F); SEAM(p0 + 1); }
            if (IN(p0 + 2)) { REP(7) { enter(F); pg8::SchedDense S; S.init(a.ws + MX_RLO, a.ws + WS_WLORA, T, 2304, 256, F.G, F.bid);
                pg8::EpiBf16P E{(bf16*)(a.ws + MX_RLORA), 2304}; pg8::gemm_phase<pg8::EpiBf16P, pg8::SchedDense, true, true>(ring, 256, S, E, F.wave); } SEAM(p0 + 2); }
            if (IN(p0 + 3)) { REP(6) phase_rwkv_chunk(a, F); SEAM(p0 + 3); }
            if (IN(p0 + 4)) { REP(8) phase_rwkv_seq(F); REP(9) phase_memattn_mfma(F, mq, BATCH * 12); SEAM(p0 + 4); }
            if (IN(p0 + 5)) { REP(7) phase_rwkv_out(a, F); SEAM(p0 + 5); }
        }
        if (IN(p0 + 6)) { REP(10) { enter(F);
            pg8::SchedDense S; S.init(a.ws + WS_CAT, a.ws + WS_WOUT + (size_t)L * D * D * 2, T, D, D, F.G, F.bid);
            pg8::EpiResid E{(const bf16*)(a.ws + WS_XB), (bf16*)(a.ws + WS_Z), D, DEEP_ALPHA};
            pg8::gemm_phase<pg8::EpiResid, pg8::SchedDense, true, true>(ring, D, S, E, F.wave); } SEAM(p0 + 6);
        }
        if (IN(p0 + 7)) { phase_moe_route(a, F, L); SEAM(p0 + 7); }
        if (IN(p0 + 8)) { REP(11) phase_moe_gather(F, L); SEAM(p0 + 8); }
        if (IN(p0 + 9)) { REP(12) { if (a.ph_lo > p0 + 8) moe_tables(F, L); else enter(F);
            moe_rowtab(F, 8);
            pg8::SchedMoeG S{(const char*)(a.ws + WS_X1B), (const char*)(a.ws + WS_WGU + (size_t)L * NE * 2048 * D * 2), (const PG8_LAS unsigned char*)(lds + MISC_OFF + MS_BEXP), (const PG8_LAS unsigned short*)(lds + MISC_OFF + MS_RT), *(const int*)(lds + MISC_OFF + MS_NB), D, 8, 2048, F.G, F.bid};
            pg8::EpiSwiglu E{(bf16*)(a.ws + WS_ACT), a.in[I_BGU] + (size_t)L * NE * 2048};
            pg8::gemm_phase<pg8::EpiSwiglu, pg8::SchedMoeG, true, true>(ring, D, S, E, F.wave); } SEAM(p0 + 9); }
        if (IN(p0 + 10)) { REP(13) { if (a.ph_lo > p0 + 8) moe_tables(F, L); else enter(F);
            pg8::SchedMoe S{(const char*)(a.ws + WS_ACT), (const char*)(a.ws + WS_WDN + (size_t)L * NE * D * D * 2), (const PG8_LAS unsigned char*)(lds + MISC_OFF + MS_BEXP), *(const int*)(lds + MISC_OFF + MS_NB), D, 4, 1024, F.G, F.bid};
            pg8::EpiDown E{(bf16*)(a.ws + WS_Y), a.in[I_BDN] + (size_t)L * NE * D};
            pg8::gemm_phase<pg8::EpiDown, pg8::SchedMoe, true, true>(ring, D, S, E, F.wave); } SEAM(p0 + 10); }
        if (IN(p0 + 11)) { REP(14) phase_moe_combine(a, F, L); SEAM(p0 + 11); }
    }
#undef IN
#undef SEAM
}

extern "C" void kernel_launch(void* const* d_in, const int* in_sizes, int n_in, void* d_out, int out_size, void* d_ws, size_t ws_size, hipStream_t stream) {
    static int grid = 0;
    if (grid == 0) {
        if (n_in != 37 || out_size != T * D || ws_size < WS_END) { fprintf(stderr, "kernel_launch: unexpected problem (n_in %d, out %d, ws %zu); nothing launched\n", n_in, out_size, ws_size); grid = -1; return; }
        int dev = 0, cus = 0;
        if (hipGetDevice(&dev) != hipSuccess || hipDeviceGetAttribute(&cus, hipDeviceAttributeMultiprocessorCount, dev) != hipSuccess) { grid = -1; return; }
        if (hipFuncSetAttribute((const void*)fwd, hipFuncAttributeMaxDynamicSharedMemorySize, LDS_BYTES) != hipSuccess) { fprintf(stderr, "kernel_launch: hipFuncSetAttribute failed\n"); grid = -1; return; }
        int per_cu = 0;
        if (hipOccupancyMaxActiveBlocksPerMultiprocessor(&per_cu, (const void*)fwd, 512, LDS_BYTES) != hipSuccess || per_cu < 1) fprintf(stderr, "kernel_launch: occupancy query reports %d\n", per_cu);
        (void)hipGetLastError();
        grid = cus;
    }
    if (grid < 0) return;
    if (hipMemsetAsync((char*)d_ws + WS_CTL, 0, CTL_BYTES, stream) != hipSuccess) return;
    Args a{};
    for (int i = 0; i < 37; ++i) a.in[i] = (const float*)d_in[i];
    a.out = (float*)d_out; a.ws = (unsigned char*)d_ws;
#ifndef PROBE_MASK
#define PROBE_MASK 0
#endif
    a.probe = PROBE_MASK; a.pad = 0;
#ifndef ONE_LAUNCH
#define ONE_LAUNCH 1
#endif
    if (ONE_LAUNCH) {
        a.ph_lo = 0; a.ph_hi = NPHASES;
        hipLaunchKernelGGL(fwd, dim3(grid), dim3(512), LDS_BYTES, stream, a);
    } else {
        for (int p = 0; p < NPHASES; ++p) {
            if (p > 0) { const int L = (p - 1) / PH_PER_LAYER, k = (p - 1) % PH_PER_LAYER, kind = L % 3; if (kind == 1 && k == 5) continue; }
            a.ph_lo = p; a.ph_hi = p + 1;
            hipLaunchKernelGGL(fwd, dim3(grid), dim3(512), LDS_BYTES, stream, a);
        }
    }
}
```
